# Optimizing an MI355X kernel written in HIP

```python
import math
import jax
import jax.numpy as jnp
from jax import lax
import numpy as np

D_MODEL = 1024
BATCH = 8
SEQ = 4096
DEPTH = 2

GRID_W = 64
BLOCK_Q = 128
EPS = 1e-6
N_BRANCH = 4

A_HEADS = 4
A_DH = 128
A_WIDTH = A_HEADS * A_DH
A_CHUNK = 128
A_CONV = 3
B_HEADS = 8
B_KV = 2
B_DH = 64
B_WIDTH = B_HEADS * B_DH
ROPE_THETA = 10000.0
C_HEADS = 8
C_DH = 64
C_WIDTH = C_HEADS * C_DH
C_WIN_R = 8
C_WIN_C = 16
D_HEADS = 4
D_DH = 64
D_DV = 2 * D_DH
D_WIDTH = D_HEADS * D_DV
D_FF = ((8 * D_MODEL + 3 * 256 - 1) // (3 * 256)) * 256

SPLIT_SIZES = (
    A_WIDTH, A_WIDTH, A_WIDTH, A_WIDTH, 4 * A_HEADS,
    B_WIDTH, B_KV * B_DH, B_KV * B_DH,
    C_WIDTH, C_WIDTH, C_WIDTH,
    2 * D_HEADS * D_DH, 2 * D_HEADS * D_DH, D_WIDTH,
    N_BRANCH * D_MODEL,
)
D_IN = sum(SPLIT_SIZES)

kernel_name = "hybrid_mlstm_gqa_natten_diffattn_encoder"

F32 = jnp.float32


def rms_norm(x, g):
    xf = x.astype(F32)
    y = xf * lax.rsqrt(jnp.mean(xf * xf, axis=-1, keepdims=True) + EPS)
    return (y * g.astype(F32)).astype(x.dtype)


def centred_dwconv(x, w):
    k = w.shape[0]
    p = k // 2
    s = x.shape[1]
    xp = jnp.pad(x, ((0, 0), (p, p), (0, 0)))
    return sum(xp[:, j:j + s, :] * w[j] for j in range(k))


def sweep_query_blocks(fn, q):
    bsz, s = q.shape[:2]
    nb = s // BLOCK_Q
    qb = jnp.moveaxis(q.reshape((bsz, nb, BLOCK_Q) + q.shape[2:]), 1, 0)
    out = lax.map(lambda a: fn(a[0], a[1]), (jnp.arange(nb), qb))
    return jnp.moveaxis(out, 0, 1).reshape((bsz, s) + out.shape[3:])


def mlstm_scan(q, k, v, li, lf):
    bsz, nh, s, d = q.shape
    nc = s // A_CHUNK

    def chunks(t):
        t = t.reshape(t.shape[:2] + (nc, A_CHUNK) + t.shape[3:])
        return jnp.moveaxis(t, 2, 0)

    qc, kc, vc, lic = chunks(q), chunks(k), chunks(v), chunks(li)
    bc = jnp.cumsum(chunks(lf), axis=-1)
    lower = jnp.tril(jnp.ones((A_CHUNK, A_CHUNK), dtype=bool))

    def step(carry, xs):
        c_mat, n_vec, m = carry
        qt, kt, vt, it, bt = xs
        dmat = jnp.where(lower, bt[..., :, None] - bt[..., None, :] + it[..., None, :], -jnp.inf)
        inter = bt + m[..., None]
        mt = jnp.maximum(inter, dmat.max(-1))
        w_inter = jnp.exp(inter - mt)
        sqk = jnp.einsum('bhtd,bhsd->bhts', qt, kt) * jnp.exp(dmat - mt[..., None])
        num = (w_inter[..., None] * jnp.einsum('bhtk,bhkv->bhtv', qt, c_mat)
               + jnp.einsum('bhts,bhsv->bhtv', sqk, vt))
        den = w_inter * jnp.einsum('bhtk,bhk->bht', qt, n_vec) + sqk.sum(-1)
        ht = num / jnp.maximum(jnp.abs(den), jnp.exp(-mt))[..., None]
        bl = bt[..., -1]
        g = bl[..., None] - bt + it
        m_new = jnp.maximum(bl + m, g.max(-1))
        wc = jnp.exp(bl + m - m_new)
        ws = jnp.exp(g - m_new[..., None])
        c_new = wc[..., None, None] * c_mat + jnp.einsum('bhs,bhsk,bhsv->bhkv', ws, kt, vt)
        n_new = wc[..., None] * n_vec + jnp.einsum('bhs,bhsk->bhk', ws, kt)
        return (c_new, n_new, m_new), ht

    init = (jnp.zeros((bsz, nh, d, d), F32), jnp.zeros((bsz, nh, d), F32), jnp.zeros((bsz, nh), F32))
    _, h = lax.scan(step, init, (qc, kc, vc, lic, bc))
    return jnp.moveaxis(h, 0, 2).reshape(bsz, nh, s, d)


def mlstm_branch(q, k, v, o, gates, conv_w, gate_bias, norm_g):
    bsz, s, _ = q.shape
    dt = q.dtype
    qk = jax.nn.silu(centred_dwconv(jnp.concatenate([q, k], axis=-1), conv_w))
    q, k = jnp.split(qk, 2, axis=-1)

    def heads(t):
        return t.reshape(bsz, s, A_HEADS, A_DH).transpose(0, 2, 1, 3).astype(F32)

    qh, kh, vh = heads(q), heads(k) * (A_DH ** -0.5), heads(v)
    g = (gates.astype(F32) + gate_bias.astype(F32)).reshape(bsz, s, 4, A_HEADS).transpose(2, 0, 3, 1)
    i_fwd, f_fwd, i_bwd, f_bwd = g[0], g[1], g[2], g[3]
    h_fwd = mlstm_scan(qh, kh, vh, i_fwd, jax.nn.log_sigmoid(f_fwd))
    flip = lambda t: jnp.flip(t, axis=2)
    h_bwd = flip(mlstm_scan(flip(qh), flip(kh), flip(vh), flip(i_bwd), flip(jax.nn.log_sigmoid(f_bwd))))
    h = h_fwd + h_bwd
    mu = jnp.mean(h, axis=-1, keepdims=True)
    var = jnp.mean(jnp.square(h - mu), axis=-1, keepdims=True)
    h = (h - mu) * lax.rsqrt(var + EPS)
    h = h.transpose(0, 2, 1, 3).reshape(bsz, s, A_WIDTH) * norm_g.astype(F32)
    return (h * jax.nn.sigmoid(o.astype(F32))).astype(dt)


def axial_rope_angles(s):
    t = jnp.arange(s)
    row = (t // GRID_W).astype(F32)
    col = (t % GRID_W).astype(F32)
    n_freq = B_DH // 4
    inv = ROPE_THETA ** (-jnp.arange(n_freq, dtype=F32) / n_freq)
    return row[:, None] * inv, col[:, None] * inv


def rotate_half_rope(x, ang):
    x1, x2 = jnp.split(x, 2, axis=-1)
    c = jnp.cos(ang)[None, :, None, :]
    sn = jnp.sin(ang)[None, :, None, :]
    return jnp.concatenate([x1 * c - x2 * sn, x2 * c + x1 * sn], axis=-1)


def axial_rope(x, ang_r, ang_c):
    xr, xc = jnp.split(x, 2, axis=-1)
    return jnp.concatenate([rotate_half_rope(xr, ang_r), rotate_half_rope(xc, ang_c)], axis=-1)


def gqa_branch(q, k, v, qn_g, kn_g):
    bsz, s, _ = q.shape
    dt = q.dtype
    q = rms_norm(q.reshape(bsz, s, B_HEADS, B_DH), qn_g).astype(F32)
    k = rms_norm(k.reshape(bsz, s, B_KV, B_DH), kn_g).astype(F32)
    v = v.reshape(bsz, s, B_KV, B_DH).astype(F32)
    ang_r, ang_c = axial_rope_angles(s)
    q = axial_rope(q, ang_r, ang_c).reshape(bsz, s, B_KV, B_HEADS // B_KV, B_DH) * (B_DH ** -0.5)
    k = axial_rope(k, ang_r, ang_c)

    def block(_, qb):
        sc = jnp.einsum('bqgrd,bkgd->bgrqk', qb, k)
        p = jax.nn.softmax(sc, axis=-1)
        return jnp.einsum('bgrqk,bkgd->bqgrd', p, v)

    o = sweep_query_blocks(block, q)
    return o.reshape(bsz, s, B_WIDTH).astype(dt)


def natten_indices(s):
    rows = s // GRID_W
    wr = min(C_WIN_R, rows)
    t = jnp.arange(s)
    r = t // GRID_W
    c = t % GRID_W
    rs = jnp.clip(r - wr // 2, 0, rows - wr)
    cs = jnp.clip(c - C_WIN_C // 2, 0, GRID_W - C_WIN_C)
    kr = rs[:, None, None] + jnp.arange(wr)[None, :, None]
    kc = cs[:, None, None] + jnp.arange(C_WIN_C)[None, None, :]
    shape = (s, wr, C_WIN_C)
    idx = jnp.broadcast_to(kr * GRID_W + kc, shape).reshape(s, wr * C_WIN_C)
    off_r = jnp.broadcast_to(kr - r[:, None, None] + (C_WIN_R - 1), shape).reshape(s, wr * C_WIN_C)
    off_c = jnp.broadcast_to(kc - c[:, None, None] + (C_WIN_C - 1), shape).reshape(s, wr * C_WIN_C)
    return idx, off_r, off_c


def natten_branch(q, k, v, rpb):
    bsz, s, _ = q.shape
    dt = q.dtype
    rows = s // GRID_W
    idx, off_r, off_c = natten_indices(s)
    nk = idx.shape[-1]
    bias = rpb.astype(F32)[:, off_r, off_c]
    q = q.reshape(bsz, rows, GRID_W, C_HEADS, C_DH).astype(F32) * (C_DH ** -0.5)
    k = k.reshape(bsz, s, C_HEADS, C_DH).astype(F32)
    v = v.reshape(bsz, s, C_HEADS, C_DH).astype(F32)
    idx_rows = idx.reshape(rows, GRID_W, nk)
    bias_rows = jnp.moveaxis(bias.reshape(C_HEADS, rows, GRID_W, nk), 1, 0)

    def row_block(args):
        qr, ir, br = args
        kg = jnp.take(k, ir, axis=1)
        vg = jnp.take(v, ir, axis=1)
        sc = jnp.einsum('bqhd,bqnhd->bhqn', qr, kg) + br[None]
        p = jax.nn.softmax(sc, axis=-1)
        return jnp.einsum('bhqn,bqnhd->bqhd', p, vg)

    o = lax.map(row_block, (jnp.moveaxis(q, 1, 0), idx_rows, bias_rows))
    return jnp.moveaxis(o, 0, 1).reshape(bsz, s, C_WIDTH).astype(dt)


def diff_branch(q, k, v, lq1, lk1, lq2, lk2, subln_g, lambda_init):
    bsz, s, _ = q.shape
    dt = q.dtype
    q = q.reshape(bsz, s, 2, D_HEADS, D_DH).astype(F32) * (D_DH ** -0.5)
    k = k.reshape(bsz, s, 2, D_HEADS, D_DH).astype(F32)
    v = v.reshape(bsz, s, D_HEADS, D_DV).astype(F32)
    lam = (jnp.exp(jnp.sum(lq1.astype(F32) * lk1.astype(F32)))
           - jnp.exp(jnp.sum(lq2.astype(F32) * lk2.astype(F32))) + lambda_init)
    slopes = 2.0 ** (-8.0 * jnp.arange(1, D_HEADS + 1, dtype=F32) / D_HEADS)
    kpos = jnp.arange(s, dtype=F32)

    def block(i, qb):
        qpos = (i * BLOCK_Q + jnp.arange(BLOCK_Q)).astype(F32)
        alibi = -slopes[:, None, None] * jnp.abs(qpos[:, None] - kpos[None, :])
        sc = jnp.einsum('bqchd,bkchd->bchqk', qb, k) + alibi[None, None]
        p = jax.nn.softmax(sc, axis=-1)
        a = p[:, 0] - lam * p[:, 1]
        return jnp.einsum('bhqk,bkhv->bqhv', a, v)

    o = sweep_query_blocks(block, q)
    o = rms_norm(o, subln_g) * (1.0 - lambda_init)
    return o.reshape(bsz, s, D_WIDTH).astype(dt)


def hybrid_layer(x, layer_idx, norm1_g, w_in, a_conv_w, a_gate_bias, a_norm_g, b_qnorm_g, b_knorm_g,
                 c_rpb, d_lq1, d_lk1, d_lq2, d_lk2, d_subln_g, w_up_a, w_up_b, w_up_c, w_up_d,
                 w_out, norm2_g, w_ffn_gate, w_ffn_up, w_ffn_down):
    bsz, s, _ = x.shape
    dt = x.dtype
    h = rms_norm(x, norm1_g)
    proj = jnp.einsum('bsd,de->bse', h, w_in)
    points = [sum(SPLIT_SIZES[:i + 1]) for i in range(len(SPLIT_SIZES) - 1)]
    (aq, ak, av, ao, ag, bq, bk, bv, cq, ck, cv, dq, dk, dv, gl) = jnp.split(proj, points, axis=-1)
    y_a = mlstm_branch(aq, ak, av, ao, ag, a_conv_w, a_gate_bias, a_norm_g)
    y_b = gqa_branch(bq, bk, bv, b_qnorm_g, b_knorm_g)
    y_c = natten_branch(cq, ck, cv, c_rpb)
    lambda_init = 0.8 - 0.6 * math.exp(-0.3 * layer_idx)
    y_d = diff_branch(dq, dk, dv, d_lq1, d_lk1, d_lq2, d_lk2, d_subln_g, lambda_init)
    g = jax.nn.sigmoid(gl.astype(F32)).reshape(bsz, s, N_BRANCH, D_MODEL)
    merged = (g[:, :, 0] * (y_a @ w_up_a) + g[:, :, 1] * (y_b @ w_up_b)
              + g[:, :, 2] * (y_c @ w_up_c) + g[:, :, 3] * (y_d @ w_up_d))
    x = x + merged.astype(dt) @ w_out
    h2 = rms_norm(x, norm2_g)
    ffn = (jax.nn.silu(h2 @ w_ffn_gate) * (h2 @ w_ffn_up)) @ w_ffn_down
    return x + ffn


def setup_inputs(seed: int = 0) -> dict:
    key = jax.random.key(seed)
    ks = jax.random.split(key, 26)
    L = DEPTH
    nrm = lambda k, shape, scale: jax.random.normal(k, shape, F32) * scale
    gain = lambda k, shape: 1.0 + 0.02 * jax.random.normal(k, shape, F32)
    fb = jnp.linspace(3.0, 6.0, A_HEADS, dtype=F32)
    zh = jnp.zeros((A_HEADS,), F32)
    gate_offset = jnp.concatenate([zh, fb, zh, fb])
    return {
        "x": jax.random.normal(ks[0], (BATCH, SEQ, D_MODEL), F32),
        "norm1_g": gain(ks[1], (L, D_MODEL)),
        "w_in": nrm(ks[2], (L, D_MODEL, D_IN), D_MODEL ** -0.5),
        "a_conv_w": nrm(ks[3], (L, A_CONV, 2 * A_WIDTH), A_CONV ** -0.5),
        "a_gate_bias": gate_offset[None] + nrm(ks[4], (L, 4 * A_HEADS), 0.1),
        "a_norm_g": gain(ks[5], (L, A_WIDTH)),
        "b_qnorm_g": gain(ks[6], (L, B_DH)),
        "b_knorm_g": gain(ks[7], (L, B_DH)),
        "c_rpb": nrm(ks[8], (L, C_HEADS, 2 * C_WIN_R - 1, 2 * C_WIN_C - 1), 0.02),
        "d_lambda_q1": nrm(ks[9], (L, D_DH), 0.1),
        "d_lambda_k1": nrm(ks[10], (L, D_DH), 0.1),
        "d_lambda_q2": nrm(ks[11], (L, D_DH), 0.1),
        "d_lambda_k2": nrm(ks[12], (L, D_DH), 0.1),
        "d_subln_g": gain(ks[13], (L, D_DV)),
        "w_up_a": nrm(ks[14], (L, A_WIDTH, D_MODEL), A_WIDTH ** -0.5),
        "w_up_b": nrm(ks[15], (L, B_WIDTH, D_MODEL), B_WIDTH ** -0.5),
        "w_up_c": nrm(ks[16], (L, C_WIDTH, D_MODEL), C_WIDTH ** -0.5),
        "w_up_d": nrm(ks[17], (L, D_WIDTH, D_MODEL), D_WIDTH ** -0.5),
        "w_out": nrm(ks[18], (L, D_MODEL, D_MODEL), D_MODEL ** -0.5),
        "norm2_g": gain(ks[19], (L, D_MODEL)),
        "w_ffn_gate": nrm(ks[20], (L, D_MODEL, D_FF), D_MODEL ** -0.5),
        "w_ffn_up": nrm(ks[21], (L, D_MODEL, D_FF), D_MODEL ** -0.5),
        "w_ffn_down": nrm(ks[22], (L, D_FF, D_MODEL), D_FF ** -0.5),
        "final_g": gain(ks[23], (D_MODEL,)),
    }


def reference(x, norm1_g, w_in, a_conv_w, a_gate_bias, a_norm_g, b_qnorm_g, b_knorm_g, c_rpb,
              d_lambda_q1, d_lambda_k1, d_lambda_q2, d_lambda_k2, d_subln_g,
              w_up_a, w_up_b, w_up_c, w_up_d, w_out, norm2_g, w_ffn_gate, w_ffn_up, w_ffn_down, final_g):
    for l in range(DEPTH):
        x = hybrid_layer(x, l, norm1_g[l], w_in[l], a_conv_w[l], a_gate_bias[l], a_norm_g[l],
                         b_qnorm_g[l], b_knorm_g[l], c_rpb[l],
                         d_lambda_q1[l], d_lambda_k1[l], d_lambda_q2[l], d_lambda_k2[l], d_subln_g[l],
                         w_up_a[l], w_up_b[l], w_up_c[l], w_up_d[l], w_out[l],
                         norm2_g[l], w_ffn_gate[l], w_ffn_up[l], w_ffn_down[l])
    return rms_norm(x, final_g)
```

```cpp
#include <hip/hip_runtime.h>
#include <hip/hip_cooperative_groups.h>
#include <cstdio>
#include <cstdint>
namespace cg = cooperative_groups;

#define DI __device__ __forceinline__
#define LAS __attribute__((address_space(3)))
typedef unsigned short bf16_t;
typedef short bf16x8 __attribute__((ext_vector_type(8)));
typedef short s16x4 __attribute__((ext_vector_type(4)));
typedef float f32x4 __attribute__((ext_vector_type(4)));
typedef float f32x2 __attribute__((ext_vector_type(2)));
typedef unsigned u32x4 __attribute__((ext_vector_type(4)));
typedef unsigned u32x2 __attribute__((ext_vector_type(2)));
typedef __bf16 bf2_t __attribute__((ext_vector_type(2)));

constexpr int DM = 1024, NBATCH = 8, SEQ = 4096, T = NBATCH * SEQ, DEPTH = 2;
constexpr int HALF_T = T / 2;
constexpr int PW = 7936;
constexpr int NIN = 10240;
constexpr int DFF = 2816, NFF2 = 5632;
constexpr int C_AQ = 0, C_AK = 512, C_AV = 1024, C_AO = 1536, C_BQ = 2048, C_BK = 2560, C_BV = 2688, C_CQ = 2816, C_CK = 3328, C_CV = 3840,
              C_DQ = 4352, C_DK = 4864, C_DV = 5376, C_GL = 5888;
constexpr float LOG2E = 1.4426950408889634f;
constexpr float EPS = 1e-6f;

constexpr size_t SZ_WIN = (size_t)NIN * 1024 * 2, SZ_WUP = (size_t)4 * 1024 * 512 * 2, SZ_WOUT = (size_t)1024 * 1024 * 2,
                 SZ_WGU = (size_t)NFF2 * 1024 * 2, SZ_WD = (size_t)1024 * DFF * 2;
constexpr size_t SZ_WLAYER = SZ_WIN + SZ_WUP + SZ_WOUT + SZ_WGU + SZ_WD;
constexpr size_t WS_CTL = 0;
constexpr size_t WS_W = 16384;
constexpr size_t WS_LAM = 14336;
constexpr size_t WS_H = WS_W + 2 * SZ_WLAYER;
constexpr size_t WS_PROJ = WS_H + (size_t)T * 1024 * 2;
constexpr size_t WS_AG = WS_PROJ + (size_t)HALF_T * PW * 2;
constexpr size_t WS_CST = WS_AG + (size_t)HALF_T * 16 * 4;
constexpr size_t WS_NST = WS_CST + (size_t)32 * 32 * 16384 * 2;
constexpr size_t WS_SCAL = WS_NST + (size_t)32 * 32 * 128 * 4;
constexpr size_t WS_XR = WS_SCAL + 3 * 4096;
constexpr size_t WS_END = WS_XR + (size_t)T * 1024 * 2;
constexpr int LDS_BYTES = 131072 + 1024;

struct Params {
    const float* in[24];
    float* out;
    unsigned char* ws;
};

DI int get_tid() { int t = (int)__builtin_amdgcn_workitem_id_x(); asm volatile("" : "+v"(t)); return t; }
DI float bf2f(unsigned short u) { return __uint_as_float(((unsigned)u) << 16); }
DI unsigned pk2(float a, float b) { bf2_t v = __builtin_convertvector((f32x2){a, b}, bf2_t); return __builtin_bit_cast(unsigned, v); }
DI float lo_f(unsigned u) { return __uint_as_float(u << 16); }
DI float hi_f(unsigned u) { return __uint_as_float(u & 0xffff0000u); }
DI bf16x8 pack8(f32x4 a, f32x4 b) {
    u32x4 p; p.x = pk2(a[0], a[1]); p.y = pk2(a[2], a[3]); p.z = pk2(b[0], b[1]); p.w = pk2(b[2], b[3]);
    return __builtin_bit_cast(bf16x8, p);
}
DI f32x4 mfma16(bf16x8 a, bf16x8 b, f32x4 c) { return __builtin_amdgcn_mfma_f32_16x16x32_bf16(a, b, c, 0, 0, 0); }
DI s16x4 tr_read(const unsigned char* p) { return __builtin_amdgcn_ds_read_tr16_b64_v4i16((LAS s16x4*)p); }
DI bf16x8 tr_pair(const unsigned char* p0, const unsigned char* p1) {
    s16x4 lo = tr_read(p0), hi = tr_read(p1);
    return __builtin_shufflevector(lo, hi, 0, 1, 2, 3, 4, 5, 6, 7);
}
DI float wave_sum(float v) {
#pragma unroll
    for (int o = 1; o < 64; o <<= 1) v += __shfl_xor(v, o);
    return v;
}
DI float quad_sum(float v) { v += __shfl_xor(v, 16); v += __shfl_xor(v, 32); return v; }
typedef unsigned u32x2s __attribute__((ext_vector_type(2)));
DI float quad_max(float v) {
    unsigned u = __float_as_uint(v);
    u32x2s r = __builtin_amdgcn_permlane16_swap(u, u, false, false);
    v = fmaxf(__uint_as_float(r[0]), __uint_as_float(r[1]));
    u = __float_as_uint(v);
    r = __builtin_amdgcn_permlane32_swap(u, u, false, false);
    return fmaxf(__uint_as_float(r[0]), __uint_as_float(r[1]));
}
DI float fexp2(float x) { return __builtin_amdgcn_exp2f(x); }
DI float fexp(float x) { return __builtin_amdgcn_exp2f(x * LOG2E); }
DI float sigmoidf_(float x) { return __builtin_amdgcn_rcpf(1.f + fexp(-x)); }
static_assert(PW * 2 == C_GL * 2 + 4096, "row pitch = bf16 columns + gate bytes");
constexpr int GATE_BYTE0 = C_GL * 2;
DI unsigned q8x4(float a, float b, float c, float d) {
    unsigned r = 0u;
    r = __builtin_amdgcn_cvt_pk_u8_f32(a * 255.f, 0, r); r = __builtin_amdgcn_cvt_pk_u8_f32(b * 255.f, 1, r);
    r = __builtin_amdgcn_cvt_pk_u8_f32(c * 255.f, 2, r); r = __builtin_amdgcn_cvt_pk_u8_f32(d * 255.f, 3, r);
    return r;
}
DI float ub0(unsigned u) { return (float)(u & 0xffu) * (1.f / 255.f); }
DI float ub1(unsigned u) { return (float)((u >> 8) & 0xffu) * (1.f / 255.f); }
DI float ub2(unsigned u) { return (float)((u >> 16) & 0xffu) * (1.f / 255.f); }
DI float ub3(unsigned u) { return (float)(u >> 24) * (1.f / 255.f); }

DI int map_in(int n) {
    if (n < 2048) return n;
    if (n < 4352) return n + 16;
    if (n < 5376) { const int base = n < 4864 ? 4352 : 4864; const int r = n - base; const int h = r >> 7, c = (r >> 6) & 1, i = r & 63; return base + 16 + c * 256 + h * 64 + i; }
    if (n < 9984) return n + 16;
    if (n < 10000) return 2048 + (n - 9984);
    return -1;
}
template <int MODE>
DI void conv_mat(const float* __restrict__ W, const float* __restrict__ W2, int K, int Nsrc, bf16_t* __restrict__ Wt, int Ndst, int gtid, int nth) {
    const int items = Ndst * (K / 8);
    for (int it = gtid; it < items; it += nth) {
        const int n = it % Ndst, kc = it / Ndst;
        const float* src = W; int col = n;
        if (MODE == 1) col = map_in(n);
        if (MODE == 2) { const int j = n >> 8, r = n & 255; src = (r < 128) ? W : W2; col = 128 * j + (r & 127); }
        float v[8];
#pragma unroll
        for (int j = 0; j < 8; ++j) v[j] = (col >= 0) ? src[(size_t)(kc * 8 + j) * Nsrc + col] : 0.f;
        u32x4 o; o.x = pk2(v[0], v[1]); o.y = pk2(v[2], v[3]); o.z = pk2(v[4], v[5]); o.w = pk2(v[6], v[7]);
        *(u32x4*)(Wt + (size_t)n * K + kc * 8) = o;
    }
}

DI void norm_rows(const float* __restrict__ x, const float* __restrict__ g, bf16_t* hout, float* fout, int nrows, bf16_t* xcopy = nullptr) {
    const int lane = get_tid() & 63, gw = blockIdx.x * 8 + (get_tid() >> 6), NW = gridDim.x * 8;
    for (int r = gw; r < nrows; r += NW) {
        const f32x4* xr = (const f32x4*)(x + (size_t)r * 1024) + lane;
        f32x4 v[4]; float s = 0.f;
#pragma unroll
        for (int j = 0; j < 4; ++j) { v[j] = xr[64 * j]; s += v[j][0] * v[j][0] + v[j][1] * v[j][1] + v[j][2] * v[j][2] + v[j][3] * v[j][3];
            if (xcopy) { u32x2 o; o.x = pk2(v[j][0], v[j][1]); o.y = pk2(v[j][2], v[j][3]); ((u32x2*)(xcopy + (size_t)r * 1024))[lane + 64 * j] = o; } }
        s = wave_sum(s);
        const float rstd = rsqrtf(s * (1.f / 1024.f) + EPS);
#pragma unroll
        for (int j = 0; j < 4; ++j) {
            const f32x4 gv = ((const f32x4*)g)[lane + 64 * j];
            const f32x4 y = v[j] * rstd * gv;
            if (hout) { u32x2 o; o.x = pk2(y[0], y[1]); o.y = pk2(y[2], y[3]); ((u32x2*)(hout + (size_t)r * 1024))[lane + 64 * j] = o; }
            else ((f32x4*)(fout + (size_t)r * 1024))[lane + 64 * j] = y;
        }
    }
}

DI void norm_rows_b(const bf16_t* __restrict__ x, const float* __restrict__ g, bf16_t* hout, float* fout, int nrows) {
    const int lane = get_tid() & 63, gw = blockIdx.x * 8 + (get_tid() >> 6), NW = gridDim.x * 8;
    for (int r = gw; r < nrows; r += NW) {
        const u32x4* xr = (const u32x4*)(x + (size_t)r * 1024) + lane;
        float v[2][8]; float s = 0.f;
#pragma unroll
        for (int j = 0; j < 2; ++j) { const u32x4 u = xr[64 * j];
            v[j][0] = lo_f(u.x); v[j][1] = hi_f(u.x); v[j][2] = lo_f(u.y); v[j][3] = hi_f(u.y); v[j][4] = lo_f(u.z); v[j][5] = hi_f(u.z); v[j][6] = lo_f(u.w); v[j][7] = hi_f(u.w);
#pragma unroll
            for (int e = 0; e < 8; ++e) s += v[j][e] * v[j][e]; }
        s = wave_sum(s);
        const float rstd = rsqrtf(s * (1.f / 1024.f) + EPS);
#pragma unroll
        for (int j = 0; j < 2; ++j) { const int c0 = (lane + 64 * j) * 8; const f32x4 g0 = *(const f32x4*)(g + c0), g1 = *(const f32x4*)(g + c0 + 4);
            const f32x4 y0 = (f32x4){v[j][0], v[j][1], v[j][2], v[j][3]} * rstd * g0, y1 = (f32x4){v[j][4], v[j][5], v[j][6], v[j][7]} * rstd * g1;
            if (hout) { u32x4 o; o.x = pk2(y0[0], y0[1]); o.y = pk2(y0[2], y0[3]); o.z = pk2(y1[0], y1[1]); o.w = pk2(y1[2], y1[3]); *(u32x4*)(hout + (size_t)r * 1024 + c0) = o; }
            else { *(f32x4*)(fout + (size_t)r * 1024 + c0) = y0; *(f32x4*)(fout + (size_t)r * 1024 + c0 + 4) = y1; } }
    }
}

DI void gemm_accum(f32x4 (&acc)[4][4], const bf16_t* __restrict__ A, int lda, const bf16_t* __restrict__ B, int ldb, int K, unsigned char* smem) {
    const int tid = get_tid(), lane = tid & 63, w = tid >> 6, wr = w >> 1, wc = w & 1, l15 = lane & 15, quad = lane >> 4;
    bf16_t* As = (bf16_t*)smem;
    bf16_t* Bs = As + 2 * 256 * 80;
    const int arow = tid >> 3, ach = tid & 7;
    const int brow = (arow & ~31) + 16 * ((arow >> 2) & 1) + 4 * ((arow >> 3) & 3) + (arow & 3);
    const bf16_t* ap = A + (size_t)arow * lda + ach * 8;
    const bf16_t* bp = B + (size_t)arow * ldb + ach * 8;
    u32x4 ra[4], rb[2];
#pragma unroll
    for (int i = 0; i < 4; ++i) ra[i] = *(const u32x4*)(ap + (size_t)(64 * i) * lda);
#pragma unroll
    for (int i = 0; i < 2; ++i) rb[i] = *(const u32x4*)(bp + (size_t)(64 * i) * ldb);
    __syncthreads();
#pragma unroll
    for (int i = 0; i < 4; ++i) *(u32x4*)(As + (arow + 64 * i) * 80 + ach * 8) = ra[i];
#pragma unroll
    for (int i = 0; i < 2; ++i) *(u32x4*)(Bs + (brow + 64 * i) * 80 + ach * 8) = rb[i];
    __syncthreads();
    const int nk = K >> 6;
    for (int kt = 0; kt < nk; ++kt) {
        const int cur = kt & 1;
        const bool more = (kt + 1 < nk);
        { const int nk_ = more ? kt + 1 : kt;
#pragma unroll
            for (int i = 0; i < 4; ++i) ra[i] = *(const u32x4*)(ap + (size_t)(64 * i) * lda + nk_ * 64);
#pragma unroll
            for (int i = 0; i < 2; ++i) rb[i] = *(const u32x4*)(bp + (size_t)(64 * i) * ldb + nk_ * 64);
        }
        __builtin_amdgcn_sched_barrier(0);
        const bf16_t* Ac = As + cur * 256 * 80 + (wr * 64 + l15) * 80 + quad * 8;
        const bf16_t* Bc = Bs + cur * 128 * 80 + (wc * 64 + l15) * 80 + quad * 8;
#pragma unroll
        for (int s = 0; s < 2; ++s) {
            bf16x8 af[4], bfr[4];
#pragma unroll
            for (int mi = 0; mi < 4; ++mi) af[mi] = *(const bf16x8*)(Ac + mi * 16 * 80 + s * 32);
#pragma unroll
            for (int ni = 0; ni < 4; ++ni) bfr[ni] = *(const bf16x8*)(Bc + ni * 16 * 80 + s * 32);
#pragma unroll
            for (int mi = 0; mi < 4; ++mi)
#pragma unroll
                for (int ni = 0; ni < 4; ++ni) acc[mi][ni] = mfma16(bfr[ni], af[mi], acc[mi][ni]);
        }
        if (more) {
#pragma unroll
            for (int i = 0; i < 4; ++i) *(u32x4*)(As + (cur ^ 1) * 256 * 80 + (arow + 64 * i) * 80 + ach * 8) = ra[i];
#pragma unroll
            for (int i = 0; i < 2; ++i) *(u32x4*)(Bs + (cur ^ 1) * 128 * 80 + (brow + 64 * i) * 80 + ach * 8) = rb[i];
        }
        __syncthreads();
    }
}
DI void zero_acc(f32x4 (&acc)[4][4]) {
#pragma unroll
    for (int i = 0; i < 4; ++i)
#pragma unroll
        for (int j = 0; j < 4; ++j) acc[i][j] = (f32x4){0.f, 0.f, 0.f, 0.f};
}
DI int vt_total(int MT, int NT) { return (MT / 4) * ((NT + 7) >> 3) * 32; }
DI bool vt_map(int v, int MT, int NT, int& mt, int& nt) {
    const int ncc = (NT + 7) >> 3; const int c = v >> 5, within = v & 31; const int cr = c / ncc, cn = c % ncc;
    mt = cr * 4 + (within & 3); nt = cn * 8 + (within >> 2); return nt < NT && mt < MT;
}
DI int vt_index(int it) { const int G = gridDim.x, b = blockIdx.x; if ((G & 7) == 0) return it * G + (b & 7) * (G >> 3) + (b >> 3); return it * G + b; }

template <int MODE>
DI void gemm_phase(const bf16_t* A, int lda, const bf16_t* Bt, int K, int M, int N, const Params& P, int hb, const float* resid, unsigned char* smem, int do_store = 1) {
    const int MT = M / 256, NT = N / 128, total = vt_total(MT, NT);
    const int tid = get_tid(), lane = tid & 63, w = tid >> 6, wr = w >> 1, wc = w & 1, l15 = lane & 15, quad = lane >> 4;
    bf16_t* proj = (bf16_t*)(P.ws + WS_PROJ);
    float* ag = (float*)(P.ws + WS_AG);
    for (int it = 0;; ++it) {
        const int v = vt_index(it); if (v >= total) break;
        int mt, nt; if (!vt_map(v, MT, NT, mt, nt)) continue;
        f32x4 acc[4][4]; zero_acc(acc);
        gemm_accum(acc, A + (size_t)mt * 256 * lda, lda, Bt + (size_t)nt * 128 * K, K, K, smem);
        const int rbase = mt * 256 + wr * 64 + l15, cbase = nt * 128 + wc * 64 + quad * 4;
#pragma unroll
        for (int mi = 0; mi < 4; ++mi) {
            const int row = rbase + mi * 16;
            if (MODE == 0) {
                if (nt < 78) {
#pragma unroll
                    for (int ni = 0; ni < 4; ++ni) { u32x2 o; o.x = pk2(acc[mi][ni][0], acc[mi][ni][1]); o.y = pk2(acc[mi][ni][2], acc[mi][ni][3]);
                        *(u32x2*)(proj + (size_t)row * PW + cbase + ni * 16) = o; }
                } else if (wc == 0) {
                    *(f32x4*)(ag + (size_t)row * 16 + quad * 4) = acc[mi][0];
                }
            } else if (MODE == 1 || MODE == 3) {
#pragma unroll
                for (int ni = 0; ni < 4; ++ni) { const size_t off = (size_t)row * 1024 + cbase + ni * 16; const f32x4 r = *(const f32x4*)(resid + off); if (do_store) *(f32x4*)(P.out + off) = r + acc[mi][ni]; }
            } else if (MODE == 2) {
                bf16_t* hid = proj;
#pragma unroll
                for (int nj = 0; nj < 2; ++nj) { const f32x4 g = acc[mi][2 * nj], u = acc[mi][2 * nj + 1]; float y[4];
#pragma unroll
                    for (int e = 0; e < 4; ++e) y[e] = g[e] * sigmoidf_(g[e]) * u[e];
                    const int hc = (nt * 128 + wc * 64 + nj * 32) / 2 + quad * 4;
                    u32x2 o; o.x = pk2(y[0], y[1]); o.y = pk2(y[2], y[3]); *(u32x2*)(hid + (size_t)row * DFF + hc) = o; }
            }
        }
    }
}

namespace pg8 {
#define PG8_LAS __attribute__((address_space(3)))
constexpr int BM = 256, BK = 64, HALF = 128, HTB = HALF * BK * 2  , STAGE_BYTES = 8 * HTB, NXCD = 8, WGM = 8;

__host__ __device__ __forceinline__ int lds_byte(int r, int c) { const int st = (r >> 4) * 2 + (c >> 5), rr = r & 15, cc = c & 31, ob = rr * 64 + cc * 2; return st * 1024 + (ob ^ (((ob >> 9) & 1) << 5)); }
__host__ __device__ __forceinline__ void stage_rc(int b, int& R, int& C) { const int st = b / 1024, sb = b % 1024, swz = sb ^ (((sb >> 9) & 1) << 5); R = (st >> 1) * 16 + swz / 64; C = (st & 1) * 32 + (swz % 64) / 2; }
__host__ __device__ __forceinline__ int perm32(int rho) { const int n = rho >> 4, i = rho & 15; return 8 * (i >> 2) + 4 * n + (i & 3); }

struct Unit { int pm, pn; };
struct Gemm { const bf16_t* A; const bf16_t* Bt; int M, N, K; };

struct StaticOrder {
    int nM, nN, nwg, G, c;
    __host__ __device__ void init(int M, int N, int G_, int c_) { nM = M / BM; nN = N / BM; nwg = nM * nN; G = G_; c = c_; }
    __host__ __device__ bool next(int i, Unit& u) const {
        const long L = (long)i * G + c; if (L >= nwg) return false;
        int wgid = (int)L; { const int q = nwg / NXCD, r = nwg % NXCD, xcd = wgid % NXCD, off = wgid / NXCD; wgid = (xcd < r ? xcd * (q + 1) : r * (q + 1) + (xcd - r) * q) + off; }
        const int nig = WGM * nN, gid = wgid / nig, fm = gid * WGM, gsz = (nM - fm) < WGM ? (nM - fm) : WGM;
        u.pm = fm + ((wgid % nig) % gsz); u.pn = (wgid % nig) / gsz; return true;
    }
    __device__ __forceinline__ void a_ready(const Unit&) const {}
    __device__ __forceinline__ void done(const Unit&) const {}
};
template <class Epi, class Sched, bool ALIGN_EPI = false, bool SP2 = false>
__device__ __forceinline__ void gemm_phase(PG8_LAS unsigned char* lds, const Gemm g, const Sched& S, const Epi& E) {
    const int tid = get_tid(), wid = __builtin_amdgcn_readfirstlane(tid >> 6), lane = tid & 63, wr = wid >> 2, wc = wid & 3, fr = lane & 15, fq = lane >> 4;
    const int K = g.K, nt = K / BK;
    unsigned voffA[2], voffB[2];
#pragma unroll
    for (int i = 0; i < 2; ++i) { int R, C; stage_rc(tid * 16 + i * 8192, R, C); const int Rb = Epi::PERM ? ((R & ~31) + perm32(R & 31)) : R;
        voffA[i] = (unsigned)(R * K + C) * 2u; voffB[i] = (unsigned)(Rb * K + C) * 2u; }
    const size_t kstep = (size_t)(BK * 2);
    const size_t hstep = (size_t)HALF * K * 2;
    const size_t tstep = 2 * hstep;
    const unsigned ldsw = (unsigned)wid * 1024u;
    const int aoff = lds_byte(wr * 64 + fr, fq * 8), boff = lds_byte(wc * 32 + fr, fq * 8);
#define PG8_SA(b, h) (((b) * 2 + (h)) * HTB)
#define PG8_SB(b, h) ((4 + (b) * 2 + (h)) * HTB)
#define PG8_STAGE(bufoff, gbase, voff) do { _Pragma("unroll") for (int _i = 0; _i < 2; ++_i) \
        __builtin_amdgcn_global_load_lds((const unsigned*)((const char*)(gbase) + (voff)[_i]), (PG8_LAS unsigned*)(lds + (bufoff) + ldsw + _i * 8192), 16, 0, 0); } while (0)
#define PG8_LDA(dst, b, h) do { _Pragma("unroll") for (int m = 0; m < 4; ++m) _Pragma("unroll") for (int k = 0; k < 2; ++k) dst[m][k] = *(const PG8_LAS bf16x8*)(lds + PG8_SA(b, h) + aoff + m * 2048 + k * 1024); } while (0)
#define PG8_LDB(dst, b, h) do { _Pragma("unroll") for (int n = 0; n < 2; ++n) _Pragma("unroll") for (int k = 0; k < 2; ++k) dst[n][k] = *(const PG8_LAS bf16x8*)(lds + PG8_SB(b, h) + boff + n * 2048 + k * 1024); } while (0)
#define PG8_MMA(ai, bj, At, Bt) do { __builtin_amdgcn_s_setprio(1); _Pragma("unroll") for (int m = 0; m < 4; ++m) _Pragma("unroll") for (int n = 0; n < 2; ++n) _Pragma("unroll") for (int k = 0; k < 2; ++k) \
        acc[ai][bj][m][n] = __builtin_amdgcn_mfma_f32_16x16x32_bf16(Bt[n][k], At[m][k], acc[ai][bj][m][n], 0, 0, 0); __builtin_amdgcn_s_setprio(0); } while (0)
#define PG8_WAIT_V(n) asm volatile("s_waitcnt vmcnt(" #n ")" ::: "memory")
#define PG8_WAIT_L(n) asm volatile("s_waitcnt lgkmcnt(" #n ")" ::: "memory")
#define PG8_BAR __builtin_amdgcn_s_barrier()
#define PG8_SCHED __builtin_amdgcn_sched_barrier(0)
    Unit cur, nxt; int ui = 0;
    if (!S.next(0, cur)) return;
    f32x4 acc[2][2][4][2];
#pragma unroll
    for (int a = 0; a < 2; ++a)
#pragma unroll
        for (int b = 0; b < 2; ++b)
#pragma unroll
            for (int m = 0; m < 4; ++m)
#pragma unroll
                for (int n = 0; n < 2; ++n) acc[a][b][m][n] = (f32x4){0.f, 0.f, 0.f, 0.f};
    bf16x8 At[4][2], B0[2][2], B1[2][2];
    const char* cA = (const char*)g.A + (size_t)cur.pm * tstep; const char* cB = (const char*)g.Bt + (size_t)cur.pn * tstep;
    S.a_ready(cur);
    if constexpr (SP2) {
        PG8_STAGE(PG8_SB(0, 0), cB, voffB); PG8_STAGE(PG8_SB(0, 1), cB + hstep, voffB); PG8_STAGE(PG8_SA(0, 0), cA, voffA); PG8_STAGE(PG8_SA(0, 1), cA + hstep, voffA);
        if (wr == 1) PG8_BAR;
        PG8_WAIT_V(2); PG8_BAR;
        PG8_STAGE(PG8_SB(1, 0), cB + kstep, voffB); PG8_STAGE(PG8_SA(1, 0), cA + kstep, voffA); PG8_STAGE(PG8_SB(1, 1), cB + hstep + kstep, voffB);
        PG8_WAIT_V(6); PG8_BAR;
    } else {
        PG8_STAGE(PG8_SB(0, 0), cB, voffB); PG8_STAGE(PG8_SA(0, 0), cA, voffA); PG8_STAGE(PG8_SB(0, 1), cB + hstep, voffB); PG8_STAGE(PG8_SA(0, 1), cA + hstep, voffA);
        if (wr == 1) PG8_BAR;
        PG8_WAIT_V(4); PG8_BAR;
        PG8_STAGE(PG8_SB(1, 0), cB + kstep, voffB); PG8_STAGE(PG8_SA(1, 0), cA + kstep, voffA); PG8_STAGE(PG8_SB(1, 1), cB + hstep + kstep, voffB);
        PG8_WAIT_V(6); PG8_BAR;
    }
    for (;;) {
        const bool has_next = S.next(ui + 1, nxt);
        const char* nA = has_next ? (const char*)g.A + (size_t)nxt.pm * tstep : cA; const char* nB = has_next ? (const char*)g.Bt + (size_t)nxt.pn * tstep : cB;
        for (int t = 0; t < nt; t += 2) {
            const bool last = (t == nt - 2);
            const char* a1 = cA + (size_t)(t + 1) * kstep;
            const char* a2 = last ? nA : cA + (size_t)(t + 2) * kstep; const char* b2 = last ? nB : cB + (size_t)(t + 2) * kstep;
            const char* a3 = a2 + kstep; const char* b3 = b2 + kstep;
            if (last && has_next) S.a_ready(nxt);
            if constexpr (SP2) {
            PG8_LDB(B0, 0, 0); PG8_LDB(B1, 0, 1); PG8_SCHED; PG8_LDA(At, 0, 0); PG8_STAGE(PG8_SA(1, 1), a1 + hstep, voffA);
            PG8_WAIT_V(8); PG8_WAIT_L(0); PG8_BAR; PG8_MMA(0, 0, At, B0); PG8_MMA(0, 1, At, B1); PG8_BAR; PG8_SCHED;
            PG8_LDA(At, 0, 1); PG8_STAGE(PG8_SB(0, 0), b2, voffB); PG8_STAGE(PG8_SB(0, 1), b2 + hstep, voffB); PG8_STAGE(PG8_SA(0, 0), a2, voffA);
            PG8_WAIT_V(8); PG8_WAIT_L(0); PG8_BAR; PG8_MMA(1, 0, At, B0); PG8_MMA(1, 1, At, B1); PG8_BAR; PG8_SCHED;
            PG8_LDB(B0, 1, 0); PG8_LDB(B1, 1, 1); PG8_SCHED; PG8_LDA(At, 1, 0); PG8_STAGE(PG8_SA(0, 1), a2 + hstep, voffA);
            PG8_WAIT_V(8); PG8_WAIT_L(0); PG8_BAR; PG8_MMA(0, 0, At, B0); PG8_MMA(0, 1, At, B1); PG8_BAR; PG8_SCHED;
            PG8_LDA(At, 1, 1); PG8_STAGE(PG8_SB(1, 0), b3, voffB); PG8_STAGE(PG8_SB(1, 1), b3 + hstep, voffB); PG8_STAGE(PG8_SA(1, 0), a3, voffA);
            PG8_WAIT_V(8); PG8_WAIT_L(0); PG8_BAR; PG8_MMA(1, 0, At, B0); PG8_MMA(1, 1, At, B1); PG8_BAR; PG8_SCHED;
            } else {
            PG8_LDB(B0, 0, 0); PG8_SCHED; PG8_LDA(At, 0, 0); PG8_STAGE(PG8_SA(1, 1), a1 + hstep, voffA);
            PG8_WAIT_L(8); PG8_BAR; PG8_WAIT_L(0); PG8_MMA(0, 0, At, B0); PG8_BAR; PG8_SCHED;
            PG8_LDB(B1, 0, 1); PG8_STAGE(PG8_SB(0, 0), b2, voffB);
            PG8_BAR; PG8_WAIT_L(0); PG8_MMA(0, 1, At, B1); PG8_BAR;
            PG8_LDA(At, 0, 1); PG8_STAGE(PG8_SA(0, 0), a2, voffA);
            PG8_BAR; PG8_WAIT_L(0); PG8_MMA(1, 0, At, B0); PG8_BAR; PG8_SCHED;
            PG8_STAGE(PG8_SB(0, 1), b2 + hstep, voffB);
            PG8_WAIT_V(6); PG8_BAR; PG8_MMA(1, 1, At, B1); PG8_BAR;
            PG8_LDB(B0, 1, 0); PG8_SCHED; PG8_LDA(At, 1, 0); PG8_STAGE(PG8_SA(0, 1), a2 + hstep, voffA);
            PG8_WAIT_L(8); PG8_BAR; PG8_WAIT_L(0); PG8_MMA(0, 0, At, B0); PG8_BAR; PG8_SCHED;
            PG8_LDB(B1, 1, 1); PG8_STAGE(PG8_SB(1, 0), b3, voffB);
            PG8_BAR; PG8_WAIT_L(0); PG8_MMA(0, 1, At, B1); PG8_BAR;
            PG8_LDA(At, 1, 1); PG8_STAGE(PG8_SA(1, 0), a3, voffA);
            PG8_BAR; PG8_WAIT_L(0); PG8_MMA(1, 0, At, B0); PG8_BAR; PG8_SCHED;
            PG8_STAGE(PG8_SB(1, 1), b3 + hstep, voffB);
            PG8_WAIT_V(6); PG8_BAR; PG8_MMA(1, 1, At, B1); PG8_BAR;
            }
        }
        if constexpr (ALIGN_EPI) { if (wr == 0) PG8_BAR; }
        if constexpr (!Epi::AFTER_DRAIN) { E(acc, cur, wr, wc, fr, fq); S.done(cur); }
        if (!has_next) break;
#pragma unroll
        for (int a = 0; a < 2; ++a)
#pragma unroll
            for (int b = 0; b < 2; ++b)
#pragma unroll
                for (int m = 0; m < 4; ++m)
#pragma unroll
                    for (int n = 0; n < 2; ++n) acc[a][b][m][n] = (f32x4){0.f, 0.f, 0.f, 0.f};
        cur = nxt; cA = nA; cB = nB; ++ui;
        if constexpr (ALIGN_EPI) { if (wr == 1) PG8_BAR; }
    }
    PG8_WAIT_V(0);
    if constexpr (!ALIGN_EPI) { if (wr == 0) PG8_BAR; }
    PG8_BAR;
    if constexpr (Epi::AFTER_DRAIN) { E.fused(acc, cur, wr, wc, fr, fq, lds, wid, lane); S.done(cur); }
#undef PG8_SA
#undef PG8_SB
#undef PG8_STAGE
#undef PG8_LDA
#undef PG8_LDB
#undef PG8_MMA
#undef PG8_WAIT_V
#undef PG8_WAIT_L
#undef PG8_BAR
#undef PG8_SCHED
}
}


struct EpiInProj {
    static constexpr bool PERM = true, AFTER_DRAIN = false;
    bf16_t* proj; float* ag;
    __device__ __forceinline__ void operator()(const f32x4 (&acc)[2][2][4][2], const pg8::Unit& u, int wr, int wc, int fr, int fq) const {
#pragma unroll
        for (int ai = 0; ai < 2; ++ai)
#pragma unroll
            for (int m = 0; m < 4; ++m) { const int row = u.pm * 256 + ai * 128 + wr * 64 + m * 16 + fr;
#pragma unroll
                for (int bj = 0; bj < 2; ++bj) { const int col = u.pn * 256 + bj * 128 + wc * 32 + fq * 8; const f32x4 v0 = acc[ai][bj][m][0], v1 = acc[ai][bj][m][1];
                    if (col < C_GL) { u32x4 o; o.x = pk2(v0[0], v0[1]); o.y = pk2(v0[2], v0[3]); o.z = pk2(v1[0], v1[1]); o.w = pk2(v1[2], v1[3]); *(u32x4*)(proj + (size_t)row * PW + col) = o; }
                    else if (col < 9984) {
                        u32x2 o; o.x = q8x4(sigmoidf_(v0[0]), sigmoidf_(v0[1]), sigmoidf_(v0[2]), sigmoidf_(v0[3])); o.y = q8x4(sigmoidf_(v1[0]), sigmoidf_(v1[1]), sigmoidf_(v1[2]), sigmoidf_(v1[3]));
                        *(u32x2*)((unsigned char*)proj + (size_t)row * (PW * 2) + GATE_BYTE0 + (col - C_GL)) = o; }
                    else if (col < 10000) { *(f32x4*)(ag + (size_t)row * 16 + (col - 9984)) = v0; *(f32x4*)(ag + (size_t)row * 16 + (col - 9984) + 4) = v1; } } }
    }
};
struct EpiResid {
    static constexpr bool PERM = true, AFTER_DRAIN = false;
    const float* resid_f; const bf16_t* resid_b; bf16_t* xout; int do_store;
    __device__ __forceinline__ void operator()(const f32x4 (&acc)[2][2][4][2], const pg8::Unit& u, int wr, int wc, int fr, int fq) const {
#pragma unroll
        for (int ai = 0; ai < 2; ++ai)
#pragma unroll
            for (int m = 0; m < 4; ++m) { const int row = u.pm * 256 + ai * 128 + wr * 64 + m * 16 + fr;
#pragma unroll
                for (int bj = 0; bj < 2; ++bj) { const size_t off = (size_t)row * 1024 + u.pn * 256 + bj * 128 + wc * 32 + fq * 8;
                    f32x4 r0, r1;
                    if (resid_f) { r0 = *(const f32x4*)(resid_f + off); r1 = *(const f32x4*)(resid_f + off + 4); }
                    else { const u32x4 q = *(const u32x4*)(resid_b + off); r0 = (f32x4){lo_f(q.x), hi_f(q.x), lo_f(q.y), hi_f(q.y)}; r1 = (f32x4){lo_f(q.z), hi_f(q.z), lo_f(q.w), hi_f(q.w)}; }
                    r0 += acc[ai][bj][m][0]; r1 += acc[ai][bj][m][1];
                    u32x4 o; o.x = pk2(r0[0], r0[1]); o.y = pk2(r0[2], r0[3]); o.z = pk2(r1[0], r1[1]); o.w = pk2(r1[2], r1[3]);
                    if (do_store) *(u32x4*)(xout + off) = o; } }
    }
};
struct EpiSwiglu {
    static constexpr bool PERM = true, AFTER_DRAIN = false;
    bf16_t* hid;
    __device__ __forceinline__ void operator()(const f32x4 (&acc)[2][2][4][2], const pg8::Unit& u, int wr, int wc, int fr, int fq) const {
#pragma unroll
        for (int ai = 0; ai < 2; ++ai)
#pragma unroll
            for (int m = 0; m < 4; ++m) { const int row = u.pm * 256 + ai * 128 + wr * 64 + m * 16 + fr;
                float y[8];
#pragma unroll
                for (int n = 0; n < 2; ++n) { const f32x4 g = acc[ai][0][m][n], up = acc[ai][1][m][n];
#pragma unroll
                    for (int e = 0; e < 4; ++e) y[4 * n + e] = g[e] * sigmoidf_(g[e]) * up[e]; }
                u32x4 o; o.x = pk2(y[0], y[1]); o.y = pk2(y[2], y[3]); o.z = pk2(y[4], y[5]); o.w = pk2(y[6], y[7]);
                *(u32x4*)(hid + (size_t)row * DFF + u.pn * 128 + wc * 32 + fq * 8) = o; }
    }
};
template <class Epi>
DI void pg8_run(const bf16_t* A, const bf16_t* Bt, int M, int N, int K, const Epi& E, unsigned char* smem) {
    pg8::Gemm g{A, Bt, M, N, K}; pg8::StaticOrder S; S.init(M, N, (int)gridDim.x, (int)blockIdx.x);
    pg8::gemm_phase<Epi, pg8::StaticOrder, true, true>((LAS unsigned char*)smem, g, S, E);
}

DI void merge_phase(const Params& P, int layer, int hb, unsigned char* smem) {
    const int MT = HALF_T / 256, NT = 8, total = vt_total(MT, NT);
    const int tid = get_tid(), lane = tid & 63, w = tid >> 6, wr = w >> 1, wc = w & 1, l15 = lane & 15, quad = lane >> 4;
    const bf16_t* proj = (const bf16_t*)(P.ws + WS_PROJ);
    const bf16_t* wup = (const bf16_t*)(P.ws + WS_W + layer * SZ_WLAYER + SZ_WIN);
    bf16_t* merged = (bf16_t*)(P.ws + WS_H) + (size_t)hb * HALF_T * 1024;
    if (__builtin_amdgcn_readfirstlane(w) >= 4) __builtin_amdgcn_s_setprio(1);
    for (int it = 0;; ++it) {
        const int v = vt_index(it); if (v >= total) break;
        int mt, nt; if (!vt_map(v, MT, NT, mt, nt)) continue;
        f32x4 tot[4][4]; zero_acc(tot);
        const int rbase = mt * 256 + wr * 64 + l15, cbase = nt * 128 + wc * 64 + quad * 8;
#pragma unroll 1
        for (int g = 0; g < 4; ++g) {
            f32x4 acc[4][4]; zero_acc(acc);
            const int ycol = g == 0 ? C_AO : (g == 1 ? C_BQ : (g == 2 ? C_CQ : C_DQ));
            gemm_accum(acc, proj + (size_t)mt * 256 * PW + ycol, PW, wup + (size_t)g * 1024 * 512 + (size_t)nt * 128 * 512, 512, 512, smem);
#pragma unroll
            for (int mi = 0; mi < 4; ++mi)
#pragma unroll
                for (int p = 0; p < 2; ++p) {
                    const u32x2 gb = *(const u32x2*)((const unsigned char*)proj + (size_t)(rbase + mi * 16) * (PW * 2) + GATE_BYTE0 + g * 1024 + cbase + p * 32);
                    tot[mi][2 * p][0] += ub0(gb.x) * acc[mi][2 * p][0]; tot[mi][2 * p][1] += ub1(gb.x) * acc[mi][2 * p][1];
                    tot[mi][2 * p][2] += ub2(gb.x) * acc[mi][2 * p][2]; tot[mi][2 * p][3] += ub3(gb.x) * acc[mi][2 * p][3];
                    tot[mi][2 * p + 1][0] += ub0(gb.y) * acc[mi][2 * p + 1][0]; tot[mi][2 * p + 1][1] += ub1(gb.y) * acc[mi][2 * p + 1][1];
                    tot[mi][2 * p + 1][2] += ub2(gb.y) * acc[mi][2 * p + 1][2]; tot[mi][2 * p + 1][3] += ub3(gb.y) * acc[mi][2 * p + 1][3];
                }
        }
#pragma unroll
        for (int mi = 0; mi < 4; ++mi)
#pragma unroll
            for (int p = 0; p < 2; ++p) { u32x4 o; o.x = pk2(tot[mi][2 * p][0], tot[mi][2 * p][1]); o.y = pk2(tot[mi][2 * p][2], tot[mi][2 * p][3]);
                o.z = pk2(tot[mi][2 * p + 1][0], tot[mi][2 * p + 1][1]); o.w = pk2(tot[mi][2 * p + 1][2], tot[mi][2 * p + 1][3]);
                *(u32x4*)(merged + (size_t)(rbase + mi * 16) * 1024 + cbase + p * 32) = o; }
    }
    __builtin_amdgcn_s_setprio(0);
}

DI void prep_b(const Params& P, int layer) {
    bf16_t* proj = (bf16_t*)(P.ws + WS_PROJ);
    const float* qg = P.in[6] + layer * 64; const float* kg = P.in[7] + layer * 64;
    const int gtid = blockIdx.x * 512 + get_tid(), nth = gridDim.x * 512;
    for (int item = gtid; item < HALF_T * 10; item += nth) {
        const int tok = item / 10, v = item % 10;
        const int col = v < 8 ? C_BQ + v * 64 : C_BK + (v - 8) * 64;
        const float* g = v < 8 ? qg : kg;
        bf16_t* p = proj + (size_t)tok * PW + col;
        float x[64];
#pragma unroll
        for (int c = 0; c < 8; ++c) { const u32x4 u = *(const u32x4*)(p + c * 8);
            x[c * 8 + 0] = lo_f(u.x); x[c * 8 + 1] = hi_f(u.x); x[c * 8 + 2] = lo_f(u.y); x[c * 8 + 3] = hi_f(u.y);
            x[c * 8 + 4] = lo_f(u.z); x[c * 8 + 5] = hi_f(u.z); x[c * 8 + 6] = lo_f(u.w); x[c * 8 + 7] = hi_f(u.w); }
        float ss = 0.f;
#pragma unroll
        for (int i = 0; i < 64; ++i) ss += x[i] * x[i];
        const float rstd = rsqrtf(ss * (1.f / 64.f) + EPS);
#pragma unroll
        for (int i = 0; i < 64; ++i) x[i] = x[i] * rstd * g[i];
        const int pos = tok & (SEQ - 1); const float frow = (float)(pos >> 6), fcol = (float)(pos & 63);
#pragma unroll
        for (int i = 0; i < 16; ++i) {
            const float inv = exp2f(-(float)i * (13.287712379549449f / 16.f));
            float ar = frow * inv * 0.15915494309189535f, ac = fcol * inv * 0.15915494309189535f;
            ar -= floorf(ar); ac -= floorf(ac);
            const float cr = __builtin_amdgcn_cosf(ar), sr = __builtin_amdgcn_sinf(ar), cc = __builtin_amdgcn_cosf(ac), sc = __builtin_amdgcn_sinf(ac);
            float a = x[i], b = x[i + 16]; x[i] = a * cr - b * sr; x[i + 16] = b * cr + a * sr;
            a = x[32 + i]; b = x[48 + i]; x[32 + i] = a * cc - b * sc; x[48 + i] = b * cc + a * sc;
        }
        const float sc_ = v < 8 ? 0.125f * LOG2E : 1.f;
#pragma unroll
        for (int c = 0; c < 8; ++c) { u32x4 u; u.x = pk2(x[c * 8] * sc_, x[c * 8 + 1] * sc_); u.y = pk2(x[c * 8 + 2] * sc_, x[c * 8 + 3] * sc_);
            u.z = pk2(x[c * 8 + 4] * sc_, x[c * 8 + 5] * sc_); u.w = pk2(x[c * 8 + 6] * sc_, x[c * 8 + 7] * sc_); *(u32x4*)(p + c * 8) = u; }
    }
}

DI void attn_b_unit(const Params& P, int unit, unsigned char* smem, int do_store = 1) {
    const int tid = get_tid(), lane = tid & 63, w = tid >> 6, l15 = lane & 15, quad = lane >> 4;
    const int wsc = __builtin_amdgcn_readfirstlane(w);
    const int qb = unit & 15, hq = (unit >> 4) & 7, b = unit >> 7, kvh = hq >> 2;
    if (wsc >= 4) __builtin_amdgcn_s_setprio(1);
    bf16_t* base = (bf16_t*)(P.ws + WS_PROJ) + (size_t)b * SEQ * PW;
    const int qrow0 = qb * 256 + w * 32;
    bf16x8 qf[2][2];
#pragma unroll
    for (int qt = 0; qt < 2; ++qt)
#pragma unroll
        for (int s = 0; s < 2; ++s) qf[qt][s] = *(const bf16x8*)(base + (size_t)(qrow0 + qt * 16 + l15) * PW + C_BQ + hq * 64 + s * 32 + quad * 8);
    bf16_t* Ks = (bf16_t*)smem;
    bf16_t* Vs = Ks + 2 * 64 * 80;
    const int lrow = tid >> 3, lch = tid & 7;
    const bf16_t* kp = base + (size_t)lrow * PW + C_BK + kvh * 64 + lch * 8;
    const bf16_t* vp = base + (size_t)lrow * PW + C_BV + kvh * 64 + lch * 8;
    u32x4 rk = *(const u32x4*)kp, rv = *(const u32x4*)vp;
    __syncthreads();
    *(u32x4*)(Ks + lrow * 80 + lch * 8) = rk; *(u32x4*)(Vs + lrow * 80 + lch * 8) = rv;
    __syncthreads();
    f32x4 o[2][4]; float m[2], l[2];
#pragma unroll
    for (int qt = 0; qt < 2; ++qt) { m[qt] = -1e30f; l[qt] = 0.f;
#pragma unroll
        for (int d = 0; d < 4; ++d) o[qt][d] = (f32x4){0.f, 0.f, 0.f, 0.f}; }
    constexpr int NKT = SEQ / 64;
    bf16x8 pb[2][2];
#pragma unroll
    for (int kg = 0; kg < 2; ++kg)
#pragma unroll
        for (int qt = 0; qt < 2; ++qt) pb[kg][qt] = (bf16x8){0, 0, 0, 0, 0, 0, 0, 0};
    f32x4 st[4][2];
    auto do_S = [&](const bf16_t* Kc) {
#pragma unroll
        for (int k16 = 0; k16 < 4; ++k16) {
            const bf16x8 k0 = *(const bf16x8*)(Kc + (k16 * 16 + l15) * 80 + quad * 8), k1 = *(const bf16x8*)(Kc + (k16 * 16 + l15) * 80 + 32 + quad * 8);
#pragma unroll
            for (int qt = 0; qt < 2; ++qt) { f32x4 z = (f32x4){0.f, 0.f, 0.f, 0.f}; z = mfma16(k0, qf[qt][0], z); st[k16][qt] = mfma16(k1, qf[qt][1], z); }
        }
    };
    auto do_PV = [&](const unsigned char* Vc) {
#pragma unroll
        for (int kg = 0; kg < 2; ++kg)
#pragma unroll
            for (int d = 0; d < 4; ++d) {
                const unsigned char* a0 = Vc + (kg * 32 + quad * 4 + (l15 >> 2)) * 160 + (d * 16 + (l15 & 3) * 4) * 2;
                const bf16x8 va = tr_pair(a0, a0 + 16 * 160);
#pragma unroll
                for (int qt = 0; qt < 2; ++qt) o[qt][d] = mfma16(va, pb[kg][qt], o[qt][d]);
            }
    };
    auto do_softmax = [&]() {
#pragma unroll
        for (int qt = 0; qt < 2; ++qt) {
            float mx = -1e30f;
#pragma unroll
            for (int k16 = 0; k16 < 4; ++k16)
#pragma unroll
                for (int e = 0; e < 4; ++e) mx = fmaxf(mx, st[k16][qt][e]);
            const float mn = fmaxf(m[qt], quad_max(mx));
            if (__builtin_amdgcn_ballot_w64(mn > m[qt]) != 0ull) {
                const float alpha = fexp2(m[qt] - mn); m[qt] = mn; l[qt] *= alpha;
#pragma unroll
                for (int d = 0; d < 4; ++d) o[qt][d] *= alpha;
            }
            float ps = 0.f;
#pragma unroll
            for (int k16 = 0; k16 < 4; ++k16)
#pragma unroll
                for (int e = 0; e < 4; ++e) { const float p = fexp2(st[k16][qt][e] - mn); st[k16][qt][e] = p; ps += p; }
            l[qt] += ps;
            pb[0][qt] = pack8(st[0][qt], st[1][qt]); pb[1][qt] = pack8(st[2][qt], st[3][qt]);
        }
    };
    int vprev = 0, vcur = 0, vnext = 1;
    if (wsc < 4) {
        for (int kt = 0; kt < NKT; ++kt) {
            const int cur = kt & 1;
            { const int nk_ = kt + 1 < NKT ? kt + 1 : kt; rk = *(const u32x4*)(kp + (size_t)nk_ * 64 * PW); rv = *(const u32x4*)(vp + (size_t)nk_ * 64 * PW); }
            do_S(Ks + cur * 64 * 80);
            do_PV((const unsigned char*)(Vs + vprev * 64 * 80));
            do_softmax();
            { *(u32x4*)(Ks + (cur ^ 1) * 64 * 80 + lrow * 80 + lch * 8) = rk; *(u32x4*)(Vs + vnext * 64 * 80 + lrow * 80 + lch * 8) = rv; }
            vprev = vcur; vcur = vnext; vnext = vnext == 2 ? 0 : vnext + 1;
            __syncthreads();
        }
        do_PV((const unsigned char*)(Vs + vprev * 64 * 80));
    } else {
        for (int kt = 0; kt < NKT; ++kt) {
            const int cur = kt & 1;
            { const int nk_ = kt + 1 < NKT ? kt + 1 : kt; rk = *(const u32x4*)(kp + (size_t)nk_ * 64 * PW); rv = *(const u32x4*)(vp + (size_t)nk_ * 64 * PW); }
            if (kt > 0) do_softmax();
            do_S(Ks + cur * 64 * 80);
            do_PV((const unsigned char*)(Vs + vprev * 64 * 80));
            { *(u32x4*)(Ks + (cur ^ 1) * 64 * 80 + lrow * 80 + lch * 8) = rk; *(u32x4*)(Vs + vnext * 64 * 80 + lrow * 80 + lch * 8) = rv; }
            vprev = vcur; vcur = vnext; vnext = vnext == 2 ? 0 : vnext + 1;
            __syncthreads();
        }
        do_softmax();
        do_PV((const unsigned char*)(Vs + vprev * 64 * 80));
    }
    __builtin_amdgcn_s_setprio(0);
#pragma unroll
    for (int qt = 0; qt < 2; ++qt) {
        const float inv = 1.f / quad_sum(l[qt]);
        bf16_t* op = base + (size_t)(qrow0 + qt * 16 + l15) * PW + C_BQ + hq * 64 + quad * 4;
#pragma unroll
        for (int d = 0; d < 4; ++d) { u32x2 u; u.x = pk2(o[qt][d][0] * inv, o[qt][d][1] * inv); u.y = pk2(o[qt][d][2] * inv, o[qt][d][3] * inv); if (do_store) *(u32x2*)(op + d * 16) = u; }
    }
}

DI bf16x8 scale8(bf16x8 v, float s) {
    const u32x4 u = __builtin_bit_cast(u32x4, v); u32x4 r;
    r.x = pk2(lo_f(u.x) * s, hi_f(u.x) * s); r.y = pk2(lo_f(u.y) * s, hi_f(u.y) * s); r.z = pk2(lo_f(u.z) * s, hi_f(u.z) * s); r.w = pk2(lo_f(u.w) * s, hi_f(u.w) * s);
    return __builtin_bit_cast(bf16x8, r);
}
DI void attn_d_unit(const Params& P, int layer, int unit, unsigned char* smem, int do_store = 1) {
    const int tid = get_tid(), lane = tid & 63, w = tid >> 6, l15 = lane & 15, quad = lane >> 4;
    const int qb = unit & 31, h = (unit >> 5) & 3, b = unit >> 7;
    bf16_t* base = (bf16_t*)(P.ws + WS_PROJ) + (size_t)b * SEQ * PW;
    const int qrow = qb * 128 + w * 16 + l15;
    if (__builtin_amdgcn_readfirstlane(w) >= 4) __builtin_amdgcn_s_setprio(1);
    bf16x8 qf[2][2];
#pragma unroll
    for (int c = 0; c < 2; ++c)
#pragma unroll
        for (int s = 0; s < 2; ++s) qf[c][s] = scale8(*(const bf16x8*)(base + (size_t)qrow * PW + C_DQ + h * 128 + c * 64 + s * 32 + quad * 8), 0.125f * LOG2E);
    bf16_t* Ks = (bf16_t*)smem;
    bf16_t* Vs = Ks + 2 * 64 * 144;
    const int lrow = tid >> 4, lch = tid & 15;
    const bf16_t* kp = base + (size_t)lrow * PW + C_DK + h * 128 + lch * 8;
    const bf16_t* vp = base + (size_t)lrow * PW + C_DV + h * 128 + lch * 8;
    u32x4 rk[2], rv[2];
#pragma unroll
    for (int i = 0; i < 2; ++i) { rk[i] = *(const u32x4*)(kp + (size_t)(32 * i) * PW); rv[i] = *(const u32x4*)(vp + (size_t)(32 * i) * PW); }
    __syncthreads();
#pragma unroll
    for (int i = 0; i < 2; ++i) { *(u32x4*)(Ks + (lrow + 32 * i) * 144 + lch * 8) = rk[i]; *(u32x4*)(Vs + (lrow + 32 * i) * 144 + lch * 8) = rv[i]; }
    __syncthreads();
    f32x4 o[2][8]; float m[2], l[2];
#pragma unroll
    for (int c = 0; c < 2; ++c) { m[c] = -1e30f; l[c] = 0.f;
#pragma unroll
        for (int d = 0; d < 8; ++d) o[c][d] = (f32x4){0.f, 0.f, 0.f, 0.f}; }
    const float slope2 = exp2f(-2.f * (float)(h + 1)) * LOG2E;
    const float dbase = (float)(quad * 4 - qrow);
    constexpr int NKT = SEQ / 64;
    f32x4 st[2][4]; bf16x8 pb[2][2];
#pragma unroll
    for (int c = 0; c < 2; ++c)
#pragma unroll
        for (int kg = 0; kg < 2; ++kg) pb[c][kg] = (bf16x8){0, 0, 0, 0, 0, 0, 0, 0};
    auto do_S = [&](const bf16_t* Kc, int kt) {
#pragma unroll
        for (int c = 0; c < 2; ++c)
#pragma unroll
            for (int k16 = 0; k16 < 4; ++k16) {
                const bf16x8 k0 = *(const bf16x8*)(Kc + (k16 * 16 + l15) * 144 + c * 64 + quad * 8), k1 = *(const bf16x8*)(Kc + (k16 * 16 + l15) * 144 + c * 64 + 32 + quad * 8);
                f32x4 z = (f32x4){0.f, 0.f, 0.f, 0.f}; z = mfma16(k0, qf[c][0], z); z = mfma16(k1, qf[c][1], z);
                const float d0 = dbase + (float)(kt * 64 + k16 * 16);
#pragma unroll
                for (int e = 0; e < 4; ++e) z[e] = z[e] - slope2 * fabsf(d0 + (float)e);
                st[c][k16] = z;
            }
    };
    auto do_softmax = [&]() {
#pragma unroll
        for (int c = 0; c < 2; ++c) {
            float mx = -1e30f;
#pragma unroll
            for (int k16 = 0; k16 < 4; ++k16)
#pragma unroll
                for (int e = 0; e < 4; ++e) mx = fmaxf(mx, st[c][k16][e]);
            const float mn = fmaxf(m[c], quad_max(mx));
            if (__builtin_amdgcn_ballot_w64(mn > m[c]) != 0ull) {
                const float alpha = fexp2(m[c] - mn); m[c] = mn; l[c] *= alpha;
#pragma unroll
                for (int d = 0; d < 8; ++d) o[c][d] *= alpha;
            }
            float ps = 0.f;
#pragma unroll
            for (int k16 = 0; k16 < 4; ++k16)
#pragma unroll
                for (int e = 0; e < 4; ++e) { const float p = fexp2(st[c][k16][e] - mn); st[c][k16][e] = p; ps += p; }
            l[c] += ps;
            pb[c][0] = pack8(st[c][0], st[c][1]); pb[c][1] = pack8(st[c][2], st[c][3]);
        }
    };
    auto do_PV = [&](const unsigned char* Vc) {
#pragma unroll
        for (int kg = 0; kg < 2; ++kg)
#pragma unroll
            for (int d = 0; d < 8; ++d) {
                const unsigned char* a0 = Vc + (kg * 32 + quad * 4 + (l15 >> 2)) * 288 + (d * 16 + (l15 & 3) * 4) * 2;
                const bf16x8 va = tr_pair(a0, a0 + 16 * 288);
                o[0][d] = mfma16(va, pb[0][kg], o[0][d]); o[1][d] = mfma16(va, pb[1][kg], o[1][d]);
            }
    };
    int vprev = 0, vcur = 0, vnext = 1;
#define D_PREFETCH() { const int nk_ = kt + 1 < NKT ? kt + 1 : kt; _Pragma("unroll") for (int i = 0; i < 2; ++i) { rk[i] = *(const u32x4*)(kp + (size_t)(nk_ * 64 + 32 * i) * PW); rv[i] = *(const u32x4*)(vp + (size_t)(nk_ * 64 + 32 * i) * PW); } }
#define D_STAGE() { _Pragma("unroll") for (int i = 0; i < 2; ++i) { *(u32x4*)(Ks + (cur ^ 1) * 64 * 144 + (lrow + 32 * i) * 144 + lch * 8) = rk[i]; *(u32x4*)(Vs + vnext * 64 * 144 + (lrow + 32 * i) * 144 + lch * 8) = rv[i]; } \
                    vprev = vcur; vcur = vnext; vnext = vnext == 2 ? 0 : vnext + 1; }
    if (__builtin_amdgcn_readfirstlane(w) < 4) {
        for (int kt = 0; kt < NKT; ++kt) {
            const int cur = kt & 1;
            D_PREFETCH();
            do_S(Ks + cur * 64 * 144, kt);
            do_PV((const unsigned char*)(Vs + vprev * 64 * 144));
            do_softmax();
            D_STAGE();
            __syncthreads();
        }
        do_PV((const unsigned char*)(Vs + vprev * 64 * 144));
    } else {
        for (int kt = 0; kt < NKT; ++kt) {
            const int cur = kt & 1;
            D_PREFETCH();
            if (kt > 0) do_softmax();
            do_S(Ks + cur * 64 * 144, kt);
            do_PV((const unsigned char*)(Vs + vprev * 64 * 144));
            D_STAGE();
            __syncthreads();
        }
        do_softmax();
        do_PV((const unsigned char*)(Vs + vprev * 64 * 144));
    }
#undef D_PREFETCH
#undef D_STAGE
    __builtin_amdgcn_s_setprio(0);
    const float lam = ((const float*)(P.ws + WS_LAM))[layer];
    const float linit = layer == 0 ? 0.2f : 0.35550906f;
    const float i0 = 1.f / quad_sum(l[0]), i1 = lam / quad_sum(l[1]);
    float ss = 0.f;
#pragma unroll
    for (int d = 0; d < 8; ++d)
#pragma unroll
        for (int e = 0; e < 4; ++e) { const float y = o[0][d][e] * i0 - o[1][d][e] * i1; o[0][d][e] = y; ss += y * y; }
    ss = quad_sum(ss);
    const float rstd = rsqrtf(ss * (1.f / 128.f) + EPS) * (1.f - linit);
    const float* sg = P.in[13] + layer * 128;
    bf16_t* op = base + (size_t)qrow * PW + C_DQ + h * 128 + quad * 4;
#pragma unroll
    for (int d = 0; d < 8; ++d) { const f32x4 g = *(const f32x4*)(sg + d * 16 + quad * 4);
        u32x2 u; u.x = pk2(o[0][d][0] * rstd * g[0], o[0][d][1] * rstd * g[1]); u.y = pk2(o[0][d][2] * rstd * g[2], o[0][d][3] * rstd * g[3]); if (do_store) *(u32x2*)(op + d * 16) = u; }
}

DI void natten_iter(const Params& P, int u, const float* rpb_lds, unsigned char* vls, int do_store = 1) {
    const int tid = get_tid(), lane = tid & 63, h = tid >> 6, l15 = lane & 15, quad = lane >> 4;
    const int cg_ = u & 3, r = (u >> 2) & 63, b = u >> 8;
    const int c0 = cg_ * 16, kc0 = min(max(c0 - 8, 0), 32), rs = min(max(r - 4, 0), 56);
    bf16_t* base = (bf16_t*)(P.ws + WS_PROJ) + (size_t)b * SEQ * PW;
    const int qtok = r * 64 + c0 + l15;
    bf16x8 qf[2];
#pragma unroll
    for (int s = 0; s < 2; ++s) qf[s] = *(const bf16x8*)(base + (size_t)qtok * PW + C_CQ + h * 64 + s * 32 + quad * 8);
    f32x4 st[16];
#pragma unroll
    for (int k16 = 0; k16 < 16; ++k16) {
        const int ktok = (rs + (k16 >> 1)) * 64 + kc0 + (k16 & 1) * 16 + l15;
        const bf16_t* kp = base + (size_t)ktok * PW + C_CK + h * 64 + quad * 8;
        const bf16x8 k0 = *(const bf16x8*)kp, k1 = *(const bf16x8*)(kp + 32);
        f32x4 z = (f32x4){0.f, 0.f, 0.f, 0.f}; z = mfma16(k0, qf[0], z); st[k16] = mfma16(k1, qf[1], z);
    }
    const int c = c0 + l15, cs = min(max(c - 8, 0), 48);
    const float* rp = rpb_lds + h * 465;
    float mx = -1e30f;
#pragma unroll
    for (int k16 = 0; k16 < 16; ++k16) {
        const int kr = rs + (k16 >> 1);
#pragma unroll
        for (int e = 0; e < 4; ++e) {
            const int kc = kc0 + (k16 & 1) * 16 + quad * 4 + e;
            const bool valid = (kc >= cs) && (kc < cs + 16);
            const int idx = valid ? (kr - r + 7) * 31 + (kc - c + 15) : 0;
            const float s = valid ? (st[k16][e] * 0.125f + rp[idx]) * LOG2E : -1e30f;
            st[k16][e] = s; mx = fmaxf(mx, s);
        }
    }
    mx = quad_max(mx);
    float ps = 0.f;
#pragma unroll
    for (int k16 = 0; k16 < 16; ++k16)
#pragma unroll
        for (int e = 0; e < 4; ++e) { const float p = fexp2(st[k16][e] - mx); st[k16][e] = p; ps += p; }
    const float inv = 1.f / quad_sum(ps);
    f32x4 o[4];
#pragma unroll
    for (int d = 0; d < 4; ++d) o[d] = (f32x4){0.f, 0.f, 0.f, 0.f};
    unsigned char* Vw = vls + h * 10240;
    u32x4 rv[8];
#pragma unroll
    for (int i = 0; i < 8; ++i) { const int idx = lane + 64 * i, j = idx >> 3, c8 = idx & 7; const int kk = j;
        const int vtok = (rs + (kk >> 5)) * 64 + kc0 + (kk & 31);
        rv[i] = *(const u32x4*)(base + (size_t)vtok * PW + C_CV + h * 64 + c8 * 8); }
#pragma unroll
    for (int ch = 0; ch < 4; ++ch) {
        __syncthreads();
#pragma unroll
        for (int i = 0; i < 8; ++i) { const int idx = lane + 64 * i, j = idx >> 3, c8 = idx & 7; *(u32x4*)(Vw + j * 160 + c8 * 16) = rv[i]; }
        if (ch < 3) {
#pragma unroll
            for (int i = 0; i < 8; ++i) { const int idx = lane + 64 * i, j = idx >> 3, c8 = idx & 7; const int kk = (ch + 1) * 64 + j;
                const int vtok = (rs + (kk >> 5)) * 64 + kc0 + (kk & 31);
                rv[i] = *(const u32x4*)(base + (size_t)vtok * PW + C_CV + h * 64 + c8 * 8); }
        }
        __syncthreads();
#pragma unroll
        for (int kgl = 0; kgl < 2; ++kgl) {
            const bf16x8 pb = pack8(st[(2 * ch + kgl) * 2], st[(2 * ch + kgl) * 2 + 1]);
#pragma unroll
            for (int d = 0; d < 4; ++d) {
                const unsigned char* a0 = Vw + (kgl * 32 + quad * 4 + (l15 >> 2)) * 160 + (d * 16 + (l15 & 3) * 4) * 2;
                o[d] = mfma16(tr_pair(a0, a0 + 16 * 160), pb, o[d]);
            }
        }
    }
    bf16_t* op = base + (size_t)qtok * PW + C_CQ + h * 64 + quad * 4;
#pragma unroll
    for (int d = 0; d < 4; ++d) { u32x2 uo; uo.x = pk2(o[d][0] * inv, o[d][1] * inv); uo.y = pk2(o[d][2] * inv, o[d][3] * inv); if (do_store) *(u32x2*)(op + d * 16) = uo; }
}

DI float logsigmoidf_(float x) { return fminf(x, 0.f) - __logf(1.f + fexp(-fabsf(x))); }
DI void scan_add2(float e0, float e1, float& o0, float& o1, int lane) {
    float s = e0 + e1;
#pragma unroll
    for (int d = 1; d < 64; d <<= 1) { const float t = __shfl_up(s, d); if (lane >= d) s += t; }
    o1 = s; o0 = s - e1;
}
DI void scan_max2(float e0, float e1, float& o0, float& o1, int lane) {
    float s = fmaxf(e0, e1);
#pragma unroll
    for (int d = 1; d < 64; d <<= 1) { const float t = __shfl_up(s, d); if (lane >= d) s = fmaxf(s, t); }
    float prev = __shfl_up(s, 1); if (lane == 0) prev = -1e30f;
    o0 = fmaxf(prev, e0); o1 = s;
}
DI void mlstm_load_tile(const Params& P, int layer, const bf16_t* base  , int h, int pc, int dir, int which, const float* wts, bf16_t* dst) {
    const int tid = get_tid(), gch = tid & 15, pl0 = tid >> 4;
    if (which == 2) {
        u32x4 v[4];
#pragma unroll
        for (int i = 0; i < 4; ++i) v[i] = *(const u32x4*)(base + (size_t)(pc * 128 + pl0 + 32 * i) * PW + C_AV + h * 128 + gch * 8);
#pragma unroll
        for (int i = 0; i < 4; ++i) { const int pl = pl0 + 32 * i, tl = dir ? 127 - pl : pl; *(u32x4*)(dst + tl * 144 + gch * 8) = v[i]; }
        return;
    }
    const int col = (which ? C_AK : C_AQ) + h * 128 + gch * 8;
    const float* cw = P.in[3] + layer * 3072 + (which ? 512 : 0) + h * 128 + gch * 8;
    const u32x4 z4 = (u32x4){0u, 0u, 0u, 0u};
    u32x4 x0[4], x1[4], x2[4];
#pragma unroll
    for (int i = 0; i < 4; ++i) {
        const int pos = pc * 128 + pl0 + 32 * i;
        x0[i] = pos > 0 ? *(const u32x4*)(base + (size_t)(pos - 1) * PW + col) : z4;
        x1[i] = *(const u32x4*)(base + (size_t)pos * PW + col);
        x2[i] = pos < SEQ - 1 ? *(const u32x4*)(base + (size_t)(pos + 1) * PW + col) : z4;
    }
    f32x4 wv[3][2];
#pragma unroll
    for (int t = 0; t < 3; ++t) { wv[t][0] = *(const f32x4*)(cw + t * 1024); wv[t][1] = *(const f32x4*)(cw + t * 1024 + 4); }
#pragma unroll
    for (int i = 0; i < 4; ++i) {
        const int pl = pl0 + 32 * i, tl = dir ? 127 - pl : pl;
        float sc = which ? 0.08838834764831845f : 1.f;
        if (wts) sc *= wts[tl];
        const unsigned a0[4] = {x0[i].x, x0[i].y, x0[i].z, x0[i].w}, a1[4] = {x1[i].x, x1[i].y, x1[i].z, x1[i].w}, a2[4] = {x2[i].x, x2[i].y, x2[i].z, x2[i].w};
        float y[8];
#pragma unroll
        for (int j = 0; j < 4; ++j) {
            const int e0 = 2 * j, e1 = 2 * j + 1;
            const float v0 = lo_f(a0[j]) * wv[0][e0 >> 2][e0 & 3] + lo_f(a1[j]) * wv[1][e0 >> 2][e0 & 3] + lo_f(a2[j]) * wv[2][e0 >> 2][e0 & 3];
            const float v1 = hi_f(a0[j]) * wv[0][e1 >> 2][e1 & 3] + hi_f(a1[j]) * wv[1][e1 >> 2][e1 & 3] + hi_f(a2[j]) * wv[2][e1 >> 2][e1 & 3];
            y[e0] = v0 * sigmoidf_(v0) * sc; y[e1] = v1 * sigmoidf_(v1) * sc;
        }
        u32x4 outv; outv.x = pk2(y[0], y[1]); outv.y = pk2(y[2], y[3]); outv.z = pk2(y[4], y[5]); outv.w = pk2(y[6], y[7]);
        *(u32x4*)(dst + tl * 144 + gch * 8) = outv;
    }
}
DI void mlstm_gates(const Params& P, int layer, int tokbase  , int h, int dir, int lane, float& i0, float& i1, float& f0, float& f1) {
    const float* ag = (const float*)(P.ws + WS_AG);
    const float* gb = P.in[4] + layer * 16;
    const int gi = (dir ? 8 : 0) + h, gf = (dir ? 12 : 4) + h;
    const int p0 = dir ? 127 - 2 * lane : 2 * lane, p1 = dir ? 126 - 2 * lane : 2 * lane + 1;
    i0 = ag[(size_t)(tokbase + p0) * 16 + gi] + gb[gi]; i1 = ag[(size_t)(tokbase + p1) * 16 + gi] + gb[gi];
    f0 = logsigmoidf_(ag[(size_t)(tokbase + p0) * 16 + gf] + gb[gf]); f1 = logsigmoidf_(ag[(size_t)(tokbase + p1) * 16 + gf] + gb[gf]);
}
DI bf16x8 scale8v(bf16x8 v, f32x4 wa, f32x4 wb) {
    const u32x4 u = __builtin_bit_cast(u32x4, v); u32x4 r;
    r.x = pk2(lo_f(u.x) * wa[0], hi_f(u.x) * wa[1]); r.y = pk2(lo_f(u.y) * wa[2], hi_f(u.y) * wa[3]);
    r.z = pk2(lo_f(u.z) * wb[0], hi_f(u.z) * wb[1]); r.w = pk2(lo_f(u.w) * wb[2], hi_f(u.w) * wb[3]);
    return __builtin_bit_cast(bf16x8, r);
}
DI void mlstm_a1_unit(const Params& P, int layer, int unit, unsigned char* smem) {
    const int tid = get_tid(), lane = tid & 63, w = tid >> 6, l15 = lane & 15, quad = lane >> 4;
    const int pc = unit & 31, h = (unit >> 5) & 3, b = unit >> 7;
    const bf16_t* base = (const bf16_t*)(P.ws + WS_PROJ) + (size_t)b * SEQ * PW;
    bf16_t* Kw = (bf16_t*)smem;
    bf16_t* Vv = Kw + 128 * 144;
    float* wp = (float*)(Vv + 128 * 144);
    float* scal = (float*)(P.ws + WS_SCAL);
    __syncthreads();
    if (w < 2) {
        const int dir = w, c = dir ? 31 - pc : pc, slot = ((b * 4 + h) * 2 + dir) * 32 + c;
        float i0, i1, f0, f1; mlstm_gates(P, layer, b * SEQ + pc * 128, h, dir, lane, i0, i1, f0, f1);
        float b0, b1; scan_add2(f0, f1, b0, b1, lane);
        const float bl = __shfl(b1, 63);
        const float g0 = bl - b0 + i0, g1 = bl - b1 + i1;
        float mloc = fmaxf(g0, g1);
#pragma unroll
        for (int o = 1; o < 64; o <<= 1) mloc = fmaxf(mloc, __shfl_xor(mloc, o));
        const int p0 = dir ? 127 - 2 * lane : 2 * lane, p1 = dir ? 126 - 2 * lane : 2 * lane + 1;
        wp[dir * 128 + p0] = fexp(g0 - mloc); wp[dir * 128 + p1] = fexp(g1 - mloc);
        if (lane == 0) { scal[slot] = bl; scal[1024 + slot] = mloc; }
    }
    mlstm_load_tile(P, layer, base, h, pc, 0, 1, nullptr, Kw);
    mlstm_load_tile(P, layer, base, h, pc, 0, 2, nullptr, Vv);
    __syncthreads();
    f32x4 acc[2][8];
#pragma unroll
    for (int dir = 0; dir < 2; ++dir)
#pragma unroll
        for (int d = 0; d < 8; ++d) acc[dir][d] = (f32x4){0.f, 0.f, 0.f, 0.f};
    const unsigned char* Kb = (const unsigned char*)Kw; const unsigned char* Vb = (const unsigned char*)Vv;
#pragma unroll
    for (int ks = 0; ks < 4; ++ks) {
        const int trow = ks * 32 + quad * 8 + (l15 >> 2), t0 = ks * 32 + quad * 8;
        const unsigned char* ka = Kb + trow * 288 + (w * 16 + (l15 & 3) * 4) * 2;
        const bf16x8 a = tr_pair(ka, ka + 4 * 288);
        const bf16x8 a0 = scale8v(a, *(const f32x4*)(wp + t0), *(const f32x4*)(wp + t0 + 4));
        const bf16x8 a1 = scale8v(a, *(const f32x4*)(wp + 128 + t0), *(const f32x4*)(wp + 128 + t0 + 4));
#pragma unroll
        for (int d = 0; d < 8; ++d) {
            const unsigned char* va = Vb + trow * 288 + (d * 16 + (l15 & 3) * 4) * 2;
            const bf16x8 vf = tr_pair(va, va + 4 * 288);
            acc[0][d] = mfma16(a0, vf, acc[0][d]); acc[1][d] = mfma16(a1, vf, acc[1][d]);
        }
    }
#pragma unroll
    for (int dir = 0; dir < 2; ++dir) {
        const int slot = ((b * 4 + h) * 2 + dir) * 32 + (dir ? 31 - pc : pc);
        bf16_t* cst = (bf16_t*)(P.ws + WS_CST) + (size_t)slot * 16384;
#pragma unroll
        for (int d = 0; d < 8; ++d) { u32x2 u; u.x = pk2(acc[dir][d][0], acc[dir][d][1]); u.y = pk2(acc[dir][d][2], acc[dir][d][3]); *(u32x2*)(cst + (d * 16 + l15) * 128 + w * 16 + quad * 4) = u; }
    }
    if (tid < 256) { const int dir = tid >> 7, dk = tid & 127; float n = 0.f;
        for (int t = 0; t < 128; ++t) n += bf2f(Kw[t * 144 + dk]) * wp[dir * 128 + t];
        const int slot = ((b * 4 + h) * 2 + dir) * 32 + (dir ? 31 - pc : pc);
        ((float*)(P.ws + WS_NST))[(size_t)slot * 128 + dk] = n; }
}
DI void mlstm_a2(const Params& P) {
    const int gtid = blockIdx.x * 512 + get_tid(), nth = gridDim.x * 512;
    float* scal = (float*)(P.ws + WS_SCAL);
    for (int task = gtid; task < 32 * 2048 + 32 * 128; task += nth) {
        if (task < 32 * 2048) {
            const int sc = task >> 11, vec = task & 2047;
            bf16_t* p = (bf16_t*)(P.ws + WS_CST) + (size_t)sc * 32 * 16384 + vec * 8;
            float C[8]; float m = 0.f;
#pragma unroll
            for (int j = 0; j < 8; ++j) C[j] = 0.f;
            for (int cb = 0; cb < 32; cb += 8) {
                u32x4 locv[8]; float blv[8], mlv[8];
#pragma unroll
                for (int j = 0; j < 8; ++j) { locv[j] = *(const u32x4*)(p + (size_t)(cb + j) * 16384); blv[j] = scal[sc * 32 + cb + j]; mlv[j] = scal[1024 + sc * 32 + cb + j]; }
#pragma unroll
                for (int j = 0; j < 8; ++j) {
                    const int c = cb + j; const u32x4 loc = locv[j];
                    u32x4 st; st.x = pk2(C[0], C[1]); st.y = pk2(C[2], C[3]); st.z = pk2(C[4], C[5]); st.w = pk2(C[6], C[7]);
                    *(u32x4*)(p + (size_t)c * 16384) = st;
                    if (vec == 0) scal[2048 + sc * 32 + c] = m;
                    const float bl = blv[j], ml = mlv[j];
                    const float mn = fmaxf(bl + m, ml), wc = fexp(bl + m - mn), wl = fexp(ml - mn);
                    C[0] = wc * C[0] + wl * lo_f(loc.x); C[1] = wc * C[1] + wl * hi_f(loc.x); C[2] = wc * C[2] + wl * lo_f(loc.y); C[3] = wc * C[3] + wl * hi_f(loc.y);
                    C[4] = wc * C[4] + wl * lo_f(loc.z); C[5] = wc * C[5] + wl * hi_f(loc.z); C[6] = wc * C[6] + wl * lo_f(loc.w); C[7] = wc * C[7] + wl * hi_f(loc.w);
                    m = mn;
                }
            }
        } else {
            const int t2 = task - 32 * 2048, sc = t2 >> 7, dk = t2 & 127;
            float* p = (float*)(P.ws + WS_NST) + (size_t)sc * 32 * 128 + dk;
            float n = 0.f, m = 0.f;
            for (int c = 0; c < 32; ++c) {
                const float loc = p[c * 128]; p[c * 128] = n;
                const float bl = scal[sc * 32 + c], ml = scal[1024 + sc * 32 + c];
                const float mn = fmaxf(bl + m, ml), wc = fexp(bl + m - mn), wl = fexp(ml - mn);
                n = wc * n + wl * loc; m = mn;
            }
        }
    }
}
DI void mlstm_a3_unit(const Params& P, int layer, int unit, unsigned char* smem, int do_store = 1) {
    const int tid = get_tid(), lane = tid & 63, w = tid >> 6, l15 = lane & 15, quad = lane >> 4;
    const int pc = unit & 31, h = (unit >> 5) & 3, b = unit >> 7;
    bf16_t* base = (bf16_t*)(P.ws + WS_PROJ) + (size_t)b * SEQ * PW;
    bf16_t* Qs = (bf16_t*)smem; bf16_t* Ks = Qs + 128 * 144; bf16_t* Vs = Ks + 128 * 144;
    float* arr = (float*)(Vs + 128 * 144);
    const float* scal = (const float*)(P.ws + WS_SCAL);
    f32x4 hacc[8];
#pragma unroll
    for (int d = 0; d < 8; ++d) hacc[d] = (f32x4){0.f, 0.f, 0.f, 0.f};
    __syncthreads();
    if (w < 2) {
        const int dir = w, slot = ((b * 4 + h) * 2 + dir) * 32 + (dir ? 31 - pc : pc);
        const float m = scal[2048 + slot];
        float* a_s = arr + dir * 512; float* M_t = a_s + 128; float* b_t = M_t + 128;
        float i0, i1, f0, f1; mlstm_gates(P, layer, b * SEQ + pc * 128, h, dir, lane, i0, i1, f0, f1);
        float b0, b1; scan_add2(f0, f1, b0, b1, lane);
        const float a0 = i0 - b0, a1 = i1 - b1;
        float p0, p1; scan_max2(a0, a1, p0, p1, lane);
        a_s[2 * lane] = a0; a_s[2 * lane + 1] = a1; M_t[2 * lane] = fmaxf(m, p0); M_t[2 * lane + 1] = fmaxf(m, p1); b_t[2 * lane] = b0; b_t[2 * lane + 1] = b1;
    } else if (w < 4) {
        const int dir = w - 2, slot = ((b * 4 + h) * 2 + dir) * 32 + (dir ? 31 - pc : pc);
        const float* np_ = (const float*)(P.ws + WS_NST) + (size_t)slot * 128; float* nv = arr + dir * 512 + 384; nv[lane] = np_[lane]; nv[lane + 64] = np_[lane + 64];
    }
    mlstm_load_tile(P, layer, base, h, pc, 0, 0, nullptr, Qs);
    mlstm_load_tile(P, layer, base, h, pc, 0, 1, nullptr, Ks);
    mlstm_load_tile(P, layer, base, h, pc, 0, 2, nullptr, Vs);
    __syncthreads();
#pragma unroll
    for (int dir = 0; dir < 2; ++dir) {
        const int c = dir ? 31 - pc : pc, sc = (b * 4 + h) * 2 + dir, slot = sc * 32 + c;
        const float m = scal[2048 + slot];
        const float* a_s = arr + dir * 512; const float* M_t = a_s + 128; const float* b_t = M_t + 128; const float* nv = b_t + 128;
        const int tl = dir ? 127 - (w * 16 + l15) : w * 16 + l15;
        const int tp = w * 16 + l15;
        const int rsgn = dir ? -1 : 1, roff = dir ? 127 : 0;
        const int nst = dir ? 8 - w : w + 1;
        bf16x8 qf[4];
#pragma unroll
        for (int ks = 0; ks < 4; ++ks) qf[ks] = *(const bf16x8*)(Qs + tp * 144 + ks * 32 + quad * 8);
        const float Mt = M_t[tl];
        bf16x8 pbv[4]; float rs_ = 0.f;
#pragma unroll
        for (int kg = 0; kg < 4; ++kg) {
            f32x4 zz[2];
#pragma unroll
            for (int hh = 0; hh < 2; ++hh) {
                const int s16 = 2 * kg + hh;
                f32x4 z = (f32x4){0.f, 0.f, 0.f, 0.f};
                if (s16 < nst) {
#pragma unroll
                    for (int ks = 0; ks < 4; ++ks) z = mfma16(*(const bf16x8*)(Ks + (roff + rsgn * (s16 * 16 + l15)) * 144 + ks * 32 + quad * 8), qf[ks], z);
#pragma unroll
                    for (int e = 0; e < 4; ++e) { const int s = s16 * 16 + quad * 4 + e; const float dv = (s <= tl) ? fexp(a_s[s] - Mt) : 0.f; z[e] *= dv; rs_ += z[e]; }
                }
                zz[hh] = z;
            }
            pbv[kg] = pack8(zz[0], zz[1]);
        }
        const float wi = fexp(m - Mt);
        f32x4 num[8];
#pragma unroll
        for (int d = 0; d < 8; ++d) num[d] = (f32x4){0.f, 0.f, 0.f, 0.f};
        const bf16_t* ct = (const bf16_t*)(P.ws + WS_CST) + (size_t)slot * 16384;
#pragma unroll
        for (int ks = 0; ks < 4; ++ks)
#pragma unroll
            for (int d = 0; d < 8; ++d) num[d] = mfma16(*(const bf16x8*)(ct + (d * 16 + l15) * 128 + ks * 32 + quad * 8), qf[ks], num[d]);
#pragma unroll
        for (int d = 0; d < 8; ++d) num[d] *= wi;
        const unsigned char* Vb = (const unsigned char*)Vs;
#pragma unroll
        for (int kg = 0; kg < 4; ++kg) {
            if (2 * kg < nst) {
                const bf16x8 pb = pbv[kg];
#pragma unroll
                for (int d = 0; d < 8; ++d) {
                    const unsigned char* a0 = Vb + (roff + rsgn * (kg * 32 + quad * 4 + (l15 >> 2))) * 288 + (d * 16 + (l15 & 3) * 4) * 2;
                    num[d] = mfma16(tr_pair(a0, a0 + rsgn * 16 * 288), pb, num[d]);
                }
            }
        }
        float qn = 0.f;
#pragma unroll
        for (int j = 0; j < 32; ++j) qn += bf2f(Qs[tp * 144 + quad * 32 + j]) * nv[quad * 32 + j];
        qn = quad_sum(qn); rs_ = quad_sum(rs_);
        const float den = wi * qn + rs_;
        const float inv = 1.f / fmaxf(fabsf(den), fexp(-(b_t[tl] + Mt)));
#pragma unroll
        for (int d = 0; d < 8; ++d)
#pragma unroll
            for (int e = 0; e < 4; ++e) hacc[d][e] += num[d][e] * inv;
    }
    float s1 = 0.f;
#pragma unroll
    for (int d = 0; d < 8; ++d)
#pragma unroll
        for (int e = 0; e < 4; ++e) s1 += hacc[d][e];
    const float mu = quad_sum(s1) * (1.f / 128.f);
    float s2 = 0.f;
#pragma unroll
    for (int d = 0; d < 8; ++d)
#pragma unroll
        for (int e = 0; e < 4; ++e) { const float t = hacc[d][e] - mu; s2 += t * t; }
    const float rstd = rsqrtf(quad_sum(s2) * (1.f / 128.f) + EPS);
    const float* ng = P.in[5] + layer * 512 + h * 128;
    bf16_t* op = base + (size_t)(pc * 128 + w * 16 + l15) * PW + C_AO + h * 128 + quad * 4;
#pragma unroll
    for (int d = 0; d < 8; ++d) {
        const u32x2 ob = *(const u32x2*)(op + d * 16); const f32x4 g = *(const f32x4*)(ng + d * 16 + quad * 4);
        const float y0 = (hacc[d][0] - mu) * rstd * g[0] * sigmoidf_(lo_f(ob.x)), y1 = (hacc[d][1] - mu) * rstd * g[1] * sigmoidf_(hi_f(ob.x));
        const float y2 = (hacc[d][2] - mu) * rstd * g[2] * sigmoidf_(lo_f(ob.y)), y3 = (hacc[d][3] - mu) * rstd * g[3] * sigmoidf_(hi_f(ob.y));
        u32x2 u; u.x = pk2(y0, y1); u.y = pk2(y2, y3); if (do_store) *(u32x2*)(op + d * 16) = u;
    }
}


#define XB_TMO      128
#define XB_XCNT(j)  (256  + 64 * (j))
#define XB_XSUB(j)  (1280 + 64 * (j))
#define XB_XGEN(j)  (2304 + 64 * (j))
#define XB_TOP      3328
#define XB_TOPGEN   3392
#define XCD_BAR_WORDS 3456
#define XB_SPIN_CAP (1u << 18)
DI unsigned xb_ld(unsigned* p)              { return __hip_atomic_load(p, __ATOMIC_RELAXED, __HIP_MEMORY_SCOPE_AGENT); }
DI unsigned xb_add(unsigned* p, unsigned v) { return __hip_atomic_fetch_add(p, v, __ATOMIC_RELAXED, __HIP_MEMORY_SCOPE_AGENT); }
DI unsigned xb_xcc_id() { return (unsigned)__builtin_amdgcn_s_getreg((3 << 11) | 20) & 0xFu; }
#define XB_SPIN(cond, bar) do { unsigned _sp = 0; while (cond) { __builtin_amdgcn_s_sleep(1); \
    if ((++_sp & 255u) == 0u) { if (xb_ld(&(bar)[XB_TMO])) break; if (_sp > XB_SPIN_CAP) { atomicAdd(&(bar)[XB_TMO], 1u); break; } } } } while (0)
struct XcdBarrier { unsigned* bar; unsigned x; volatile LAS unsigned* st; };
DI XcdBarrier xcd_barrier_post(unsigned* bar, volatile LAS unsigned* st) {
    XcdBarrier b; b.bar = bar; b.x = xb_xcc_id(); b.st = st;
    if (threadIdx.x == 0) (void)xb_add(&bar[XB_XCNT(b.x)], 1u);
    return b;
}
DI void xcd_barrier_complete(unsigned* bar, unsigned x, unsigned& nloc, unsigned& nx) {
    const unsigned G = gridDim.x * gridDim.y * gridDim.z;
    unsigned sum, cnt, mine, sp = 0u;
    for (;;) {
        sum = 0u; cnt = 0u; mine = 0u;
#pragma unroll
        for (unsigned j = 0; j < 16; ++j) { const unsigned c = xb_ld(&bar[XB_XCNT(j)]); sum += c; cnt += (c > 0u) ? 1u : 0u; mine = (j == x) ? c : mine; }
        if (sum == G) break;
        __builtin_amdgcn_s_sleep(1);
        if ((++sp & 255u) == 0u) { if (xb_ld(&bar[XB_TMO])) break; if (sp > XB_SPIN_CAP) { atomicAdd(&bar[XB_TMO], 1u); break; } }
    }
    nloc = mine > 0u ? mine : 1u; nx = cnt > 0u ? cnt : 1u;
}
DI void xcd_barrier(const XcdBarrier& b) {
    asm volatile("s_waitcnt vmcnt(0)" ::: "memory");
    __syncthreads();
    if (threadIdx.x == 0) {
        unsigned* bar = b.bar;
        __builtin_amdgcn_s_waitcnt(0);
        unsigned nloc = b.st[0], nx = b.st[1];
        if (nloc == 0u) { xcd_barrier_complete(bar, b.x, nloc, nx); b.st[0] = nloc; b.st[1] = nx; }
        const unsigned old = xb_add(&bar[XB_XSUB(b.x)], 1u);
        const unsigned gen = old / nloc;
        if (old + 1u == (gen + 1u) * nloc) {
            __builtin_amdgcn_fence(__ATOMIC_RELEASE, "agent");
            asm volatile("s_waitcnt vmcnt(0)" ::: "memory");
            const unsigned og = xb_add(&bar[XB_TOP], 1u);
            const unsigned tg = og / nx;
            if (og + 1u == (tg + 1u) * nx) xb_add(&bar[XB_TOPGEN], 1u);
            else XB_SPIN(xb_ld(&bar[XB_TOPGEN]) == tg, bar);
            __builtin_amdgcn_fence(__ATOMIC_ACQUIRE, "agent");
            xb_add(&bar[XB_XGEN(b.x)], 1u);
            asm volatile("s_waitcnt vmcnt(0)" ::: "memory");
        } else {
            XB_SPIN(xb_ld(&bar[XB_XGEN(b.x)]) == gen, bar);
            __builtin_amdgcn_fence(__ATOMIC_ACQUIRE, "agent");
            asm volatile("s_waitcnt vmcnt(0)" ::: "memory");
        }
    }
    __syncthreads();
}

__global__ void __launch_bounds__(512) fwd_megakernel(Params P) {
    extern __shared__ __attribute__((aligned(16))) unsigned char smem[];
    cg::grid_group grid = cg::this_grid();
    const int tid = get_tid(), bid = blockIdx.x, G = gridDim.x;
    const int gtid = bid * 512 + tid, nth = G * 512;
    bf16_t* hbuf = (bf16_t*)(P.ws + WS_H);
    volatile LAS unsigned* bst = (volatile LAS unsigned*)(smem + 131072);
    if (tid < 4) bst[tid] = 0u;
    __syncthreads();
    const XcdBarrier bar = xcd_barrier_post((unsigned*)P.ws, bst);

#ifndef REP_P0
#define REP_P0 1
#endif
    for (int rp0 = 0; rp0 < REP_P0; ++rp0)
    for (int l = 0; l < DEPTH; ++l) {
        unsigned char* wl = P.ws + WS_W + l * SZ_WLAYER;
        conv_mat<1>(P.in[2] + (size_t)l * 1024 * 10000, nullptr, 1024, 10000, (bf16_t*)wl, NIN, gtid, nth);
        for (int g = 0; g < 4; ++g) conv_mat<0>(P.in[14 + g] + (size_t)l * 512 * 1024, nullptr, 512, 1024, (bf16_t*)(wl + SZ_WIN) + (size_t)g * 1024 * 512, 1024, gtid, nth);
        conv_mat<0>(P.in[18] + (size_t)l * 1024 * 1024, nullptr, 1024, 1024, (bf16_t*)(wl + SZ_WIN + SZ_WUP), 1024, gtid, nth);
        conv_mat<2>(P.in[20] + (size_t)l * 1024 * DFF, P.in[21] + (size_t)l * 1024 * DFF, 1024, DFF, (bf16_t*)(wl + SZ_WIN + SZ_WUP + SZ_WOUT), NFF2, gtid, nth);
        conv_mat<0>(P.in[22] + (size_t)l * DFF * 1024, nullptr, DFF, 1024, (bf16_t*)(wl + SZ_WIN + SZ_WUP + SZ_WOUT + SZ_WGU), 1024, gtid, nth);
    }
    if (gtid < DEPTH) {
        const int l = gtid; float d1 = 0.f, d2 = 0.f;
        for (int i = 0; i < 64; ++i) { d1 += P.in[9][l * 64 + i] * P.in[10][l * 64 + i]; d2 += P.in[11][l * 64 + i] * P.in[12][l * 64 + i]; }
        const float linit = l == 0 ? 0.2f : 0.35550906f;
        ((float*)(P.ws + WS_LAM))[l] = expf(d1) - expf(d2) + linit;
    }
    norm_rows(P.in[0], P.in[1], hbuf, nullptr, T, (bf16_t*)(P.ws + WS_XR));
    grid.sync();

#pragma unroll 1
    for (int layer_ = 0; layer_ < DEPTH; ++layer_) {
#ifndef REP_A
#define REP_A 1
#endif
#ifndef REP_N
#define REP_N 1
#endif
#ifndef REP_B
#define REP_B 1
#endif
#ifndef REP_D
#define REP_D 1
#endif
#ifndef REP_GEMM
#define REP_GEMM 1
#endif
#ifndef REP_ATTN
#define REP_ATTN 1
#endif
#define REPEAT(n) for (int rep_ = 0; rep_ < (n); ++rep_)
#define LASTREP(n) int dst_ = (rep_ == (n) - 1); asm volatile("" : "+s"(dst_));
#define LAUNDER() int layer = layer_; asm volatile("" : "+s"(layer)); Params Q = P; { size_t z_ = 0; asm volatile("" : "+s"(z_)); Q.ws = P.ws + z_; }     const unsigned char* wl = Q.ws + WS_W + layer * SZ_WLAYER; (void)wl;
#pragma unroll 1
        for (int hb_ = 0; hb_ < 2; ++hb_) {
            REPEAT(REP_GEMM) { LAUNDER(); int hb = hb_; asm volatile("" : "+s"(hb));
              EpiInProj E{(bf16_t*)(Q.ws + WS_PROJ), (float*)(Q.ws + WS_AG)}; pg8_run((const bf16_t*)(Q.ws + WS_H) + (size_t)hb * HALF_T * 1024, (const bf16_t*)wl, HALF_T, NIN, 1024, E, smem); }
            xcd_barrier(bar);
            { LAUNDER();
              prep_b(Q, layer);
              REPEAT(REP_A) for (int u = bid; u < 512; u += G) mlstm_a1_unit(Q, layer, u, smem); }
            { LAUNDER();
                float* rpb_lds = (float*)(smem + 8 * 10240);
                __syncthreads();
                for (int i = get_tid(); i < 3720; i += 512) rpb_lds[i] = Q.in[8][layer * 3720 + i];
                __syncthreads();
                REPEAT(REP_N) { LASTREP(REP_N); for (int u = vt_index(0); u < 1024; u += G) natten_iter(Q, u, rpb_lds, smem, dst_); }
            }
            xcd_barrier(bar);
            { LAUNDER(); mlstm_a2(Q); }
            REPEAT(REP_D) { LAUNDER(); LASTREP(REP_D); for (int u = vt_index(0); u < 512; u += G) attn_d_unit(Q, layer, u, smem, dst_); }
            REPEAT(REP_B) { LAUNDER(); LASTREP(REP_B); for (int u = vt_index(0); u < 512; u += G) attn_b_unit(Q, u, smem, dst_); }
            xcd_barrier(bar);
            REPEAT(REP_A) { LAUNDER(); LASTREP(REP_A); for (int u = bid; u < 512; u += G) mlstm_a3_unit(Q, layer, u, smem, dst_); }
            xcd_barrier(bar);
            REPEAT(REP_GEMM) { LAUNDER(); int hb = hb_; asm volatile("" : "+s"(hb)); merge_phase(Q, layer, hb, smem); }
            xcd_barrier(bar);
        }
        REPEAT(REP_GEMM) { LAUNDER(); LASTREP(REP_GEMM);
          bf16_t* xr = (bf16_t*)(Q.ws + WS_XR);
          EpiResid E{nullptr, xr, xr, dst_}; pg8_run((const bf16_t*)(Q.ws + WS_H), (const bf16_t*)(wl + SZ_WIN + SZ_WUP), T, 1024, 1024, E, smem); }
        xcd_barrier(bar);
        { LAUNDER(); norm_rows_b((const bf16_t*)(Q.ws + WS_XR), Q.in[19] + layer * 1024, (bf16_t*)(Q.ws + WS_H), nullptr, T); }
        xcd_barrier(bar);
        REPEAT(REP_GEMM) { LAUNDER();
          EpiSwiglu E{(bf16_t*)(Q.ws + WS_PROJ)}; pg8_run((const bf16_t*)(Q.ws + WS_H), (const bf16_t*)(wl + SZ_WIN + SZ_WUP + SZ_WOUT), T, NFF2, 1024, E, smem); }
        xcd_barrier(bar);
        REPEAT(REP_GEMM) { LAUNDER(); LASTREP(REP_GEMM);
          bf16_t* xr = (bf16_t*)(Q.ws + WS_XR);
          EpiResid E{nullptr, xr, xr, dst_}; pg8_run((const bf16_t*)(Q.ws + WS_PROJ), (const bf16_t*)(wl + SZ_WIN + SZ_WUP + SZ_WOUT + SZ_WGU), T, 1024, DFF, E, smem); }
        xcd_barrier(bar);
        { LAUNDER();
          if (layer + 1 < DEPTH) norm_rows_b((const bf16_t*)(Q.ws + WS_XR), Q.in[1] + (layer + 1) * 1024, (bf16_t*)(Q.ws + WS_H), nullptr, T);
          else norm_rows_b((const bf16_t*)(Q.ws + WS_XR), Q.in[23], nullptr, Q.out, T); }
        xcd_barrier(bar);
    }
}

extern "C" void kernel_launch(void* const* d_in, const int* in_sizes, int n_in, void* d_out, int out_size, void* d_ws, size_t ws_size, hipStream_t stream) {
    static int grid_blocks = 0;
    if (grid_blocks == 0) {
        if (n_in != 24 || out_size != T * DM || ws_size < WS_END) {
            fprintf(stderr, "kernel_launch: unexpected shapes: n_in %d out %d ws %zu (need %zu)\n", n_in, out_size, ws_size, (size_t)WS_END); grid_blocks = -1; return; }
        int dev = 0, cus = 0, per_cu = 0;
        hipGetDevice(&dev);
        hipDeviceGetAttribute(&cus, hipDeviceAttributeMultiprocessorCount, dev);
        if (hipFuncSetAttribute((const void*)fwd_megakernel, hipFuncAttributeMaxDynamicSharedMemorySize, LDS_BYTES) != hipSuccess) { fprintf(stderr, "kernel_launch: hipFuncSetAttribute failed\n"); }
        hipOccupancyMaxActiveBlocksPerMultiprocessor(&per_cu, (const void*)fwd_megakernel, 512, LDS_BYTES);
        if (per_cu < 1) { fprintf(stderr, "kernel_launch: occupancy query says %d blocks/CU\n", per_cu); per_cu = 1; }
        grid_blocks = cus;
        (void)hipGetLastError();
    }
    if (grid_blocks < 0) return;
    Params p{};
    for (int i = 0; i < 24; ++i) p.in[i] = (const float*)d_in[i];
    p.out = (float*)d_out; p.ws = (unsigned char*)d_ws;
    if (hipMemsetAsync(d_ws, 0, 16384, stream) != hipSuccess) { fprintf(stderr, "kernel_launch: memset of barrier words failed\n"); return; }
    void* args[] = {&p};
    hipError_t e = hipLaunchCooperativeKernel((const void*)fwd_megakernel, dim3(grid_blocks), dim3(512), args, LDS_BYTES, stream);
    if (e != hipSuccess) fprintf(stderr, "cooperative launch failed: %s (grid %d)\n", hipGetErrorString(e), grid_blocks);
}
```

```cpp
#include <hip/hip_runtime.h>
#include <hip/hip_cooperative_groups.h>
#include <cstdio>
#include <cstdint>
namespace cg = cooperative_groups;

#define DI __device__ __forceinline__
#define LAS __attribute__((address_space(3)))
typedef unsigned short bf16_t;
typedef short bf16x8 __attribute__((ext_vector_type(8)));
typedef short s16x4 __attribute__((ext_vector_type(4)));
typedef float f32x4 __attribute__((ext_vector_type(4)));
typedef float f32x2 __attribute__((ext_vector_type(2)));
typedef unsigned u32x4 __attribute__((ext_vector_type(4)));
typedef unsigned u32x2 __attribute__((ext_vector_type(2)));
typedef __bf16 bf2_t __attribute__((ext_vector_type(2)));

constexpr int DM = 1024, NBATCH = 8, SEQ = 4096, T = NBATCH * SEQ, DEPTH = 2;
constexpr int HALF_T = T / 2;
constexpr int PW = 7936;
constexpr int NIN = 10240;
constexpr int DFF = 2816, NFF2 = 5632;
constexpr int C_AQ = 0, C_AK = 512, C_AV = 1024, C_AO = 1536, C_BQ = 2048, C_BK = 2560, C_BV = 2688, C_CQ = 2816, C_CK = 3328, C_CV = 3840,
              C_DQ = 4352, C_DK = 4864, C_DV = 5376, C_GL = 5888;
constexpr float LOG2E = 1.4426950408889634f;
constexpr float EPS = 1e-6f;

constexpr size_t SZ_WIN = (size_t)NIN * 1024 * 2, SZ_WUP = (size_t)4 * 1024 * 512 * 2, SZ_WOUT = (size_t)1024 * 1024 * 2,
                 SZ_WGU = (size_t)NFF2 * 1024 * 2, SZ_WD = (size_t)1024 * DFF * 2;
constexpr size_t SZ_WLAYER = SZ_WIN + SZ_WUP + SZ_WOUT + SZ_WGU + SZ_WD;
constexpr size_t WS_CTL = 0;
constexpr size_t WS_W = 16384;
constexpr size_t WS_LAM = 14336;
constexpr size_t WS_H = WS_W + 2 * SZ_WLAYER;
constexpr size_t WS_PROJ = WS_H + (size_t)T * 1024 * 2;
constexpr size_t WS_AG = WS_PROJ + (size_t)HALF_T * PW * 2;
constexpr size_t WS_CST = WS_AG + (size_t)HALF_T * 16 * 4;
constexpr size_t WS_NST = WS_CST + (size_t)32 * 32 * 16384 * 2;
constexpr size_t WS_SCAL = WS_NST + (size_t)32 * 32 * 128 * 4;
constexpr size_t WS_XR = WS_SCAL + 3 * 4096;
constexpr size_t WS_END = WS_XR + (size_t)T * 1024 * 2;
constexpr int LDS_BYTES = 131072 + 1024;

struct Params {
    const float* in[24];
    float* out;
    unsigned char* ws;
};

DI int get_tid() { int t = (int)__builtin_amdgcn_workitem_id_x(); asm volatile("" : "+v"(t)); return t; }
DI float bf2f(unsigned short u) { return __uint_as_float(((unsigned)u) << 16); }
DI unsigned pk2(float a, float b) { bf2_t v = __builtin_convertvector((f32x2){a, b}, bf2_t); return __builtin_bit_cast(unsigned, v); }
DI float lo_f(unsigned u) { return __uint_as_float(u << 16); }
DI float hi_f(unsigned u) { return __uint_as_float(u & 0xffff0000u); }
DI bf16x8 pack8(f32x4 a, f32x4 b) {
    u32x4 p; p.x = pk2(a[0], a[1]); p.y = pk2(a[2], a[3]); p.z = pk2(b[0], b[1]); p.w = pk2(b[2], b[3]);
    return __builtin_bit_cast(bf16x8, p);
}
DI f32x4 mfma16(bf16x8 a, bf16x8 b, f32x4 c) { return __builtin_amdgcn_mfma_f32_16x16x32_bf16(a, b, c, 0, 0, 0); }
DI s16x4 tr_read(const unsigned char* p) { return __builtin_amdgcn_ds_read_tr16_b64_v4i16((LAS s16x4*)p); }
DI bf16x8 tr_pair(const unsigned char* p0, const unsigned char* p1) {
    s16x4 lo = tr_read(p0), hi = tr_read(p1);
    return __builtin_shufflevector(lo, hi, 0, 1, 2, 3, 4, 5, 6, 7);
}
DI float wave_sum(float v) {
#pragma unroll
    for (int o = 1; o < 64; o <<= 1) v += __shfl_xor(v, o);
    return v;
}
DI float quad_sum(float v) { v += __shfl_xor(v, 16); v += __shfl_xor(v, 32); return v; }
typedef unsigned u32x2s __attribute__((ext_vector_type(2)));
DI float quad_max(float v) {
    unsigned u = __float_as_uint(v);
    u32x2s r = __builtin_amdgcn_permlane16_swap(u, u, false, false);
    v = fmaxf(__uint_as_float(r[0]), __uint_as_float(r[1]));
    u = __float_as_uint(v);
    r = __builtin_amdgcn_permlane32_swap(u, u, false, false);
    return fmaxf(__uint_as_float(r[0]), __uint_as_float(r[1]));
}
DI float fexp2(float x) { return __builtin_amdgcn_exp2f(x); }
DI float fexp(float x) { return __builtin_amdgcn_exp2f(x * LOG2E); }
DI float sigmoidf_(float x) { return __builtin_amdgcn_rcpf(1.f + fexp(-x)); }
static_assert(PW * 2 == C_GL * 2 + 4096, "row pitch = bf16 columns + gate bytes");
constexpr int GATE_BYTE0 = C_GL * 2;
DI unsigned q8x4(float a, float b, float c, float d) {
    unsigned r = 0u;
    r = __builtin_amdgcn_cvt_pk_u8_f32(a * 255.f, 0, r); r = __builtin_amdgcn_cvt_pk_u8_f32(b * 255.f, 1, r);
    r = __builtin_amdgcn_cvt_pk_u8_f32(c * 255.f, 2, r); r = __builtin_amdgcn_cvt_pk_u8_f32(d * 255.f, 3, r);
    return r;
}
DI float ub0(unsigned u) { return (float)(u & 0xffu) * (1.f / 255.f); }
DI float ub1(unsigned u) { return (float)((u >> 8) & 0xffu) * (1.f / 255.f); }
DI float ub2(unsigned u) { return (float)((u >> 16) & 0xffu) * (1.f / 255.f); }
DI float ub3(unsigned u) { return (float)(u >> 24) * (1.f / 255.f); }

DI int map_in(int n) {
    if (n < 2048) return n;
    if (n < 4352) return n + 16;
    if (n < 5376) { const int base = n < 4864 ? 4352 : 4864; const int r = n - base; const int h = r >> 7, c = (r >> 6) & 1, i = r & 63; return base + 16 + c * 256 + h * 64 + i; }
    if (n < 9984) return n + 16;
    if (n < 10000) return 2048 + (n - 9984);
    return -1;
}
template <int MODE>
DI void conv_mat(const float* __restrict__ W, const float* __restrict__ W2, int K, int Nsrc, bf16_t* __restrict__ Wt, int Ndst, int gtid, int nth) {
    const int items = Ndst * (K / 8);
    for (int it = gtid; it < items; it += nth) {
        const int n = it % Ndst, kc = it / Ndst;
        const float* src = W; int col = n;
        if (MODE == 1) col = map_in(n);
        if (MODE == 2) { const int j = n >> 8, r = n & 255; src = (r < 128) ? W : W2; col = 128 * j + (r & 127); }
        float v[8];
#pragma unroll
        for (int j = 0; j < 8; ++j) v[j] = (col >= 0) ? src[(size_t)(kc * 8 + j) * Nsrc + col] : 0.f;
        u32x4 o; o.x = pk2(v[0], v[1]); o.y = pk2(v[2], v[3]); o.z = pk2(v[4], v[5]); o.w = pk2(v[6], v[7]);
        *(u32x4*)(Wt + (size_t)n * K + kc * 8) = o;
    }
}

DI void norm_rows(const float* __restrict__ x, const float* __restrict__ g, bf16_t* hout, float* fout, int nrows) {
    const int lane = get_tid() & 63, gw = blockIdx.x * 8 + (get_tid() >> 6), NW = gridDim.x * 8;
    for (int r = gw; r < nrows; r += NW) {
        const f32x4* xr = (const f32x4*)(x + (size_t)r * 1024) + lane;
        f32x4 v[4]; float s = 0.f;
#pragma unroll
        for (int j = 0; j < 4; ++j) { v[j] = xr[64 * j]; s += v[j][0] * v[j][0] + v[j][1] * v[j][1] + v[j][2] * v[j][2] + v[j][3] * v[j][3]; }
        s = wave_sum(s);
        const float rstd = rsqrtf(s * (1.f / 1024.f) + EPS);
#pragma unroll
        for (int j = 0; j < 4; ++j) {
            const f32x4 gv = ((const f32x4*)g)[lane + 64 * j];
            const f32x4 y = v[j] * rstd * gv;
            if (hout) { u32x2 o; o.x = pk2(y[0], y[1]); o.y = pk2(y[2], y[3]); ((u32x2*)(hout + (size_t)r * 1024))[lane + 64 * j] = o; }
            else ((f32x4*)(fout + (size_t)r * 1024))[lane + 64 * j] = y;
        }
    }
}

DI void norm_rows_b(const bf16_t* __restrict__ x, const float* __restrict__ g, bf16_t* hout, float* fout, int nrows) {
    const int lane = get_tid() & 63, gw = blockIdx.x * 8 + (get_tid() >> 6), NW = gridDim.x * 8;
    for (int r = gw; r < nrows; r += NW) {
        const u32x4* xr = (const u32x4*)(x + (size_t)r * 1024) + lane;
        float v[2][8]; float s = 0.f;
#pragma unroll
        for (int j = 0; j < 2; ++j) { const u32x4 u = xr[64 * j];
            v[j][0] = lo_f(u.x); v[j][1] = hi_f(u.x); v[j][2] = lo_f(u.y); v[j][3] = hi_f(u.y); v[j][4] = lo_f(u.z); v[j][5] = hi_f(u.z); v[j][6] = lo_f(u.w); v[j][7] = hi_f(u.w);
#pragma unroll
            for (int e = 0; e < 8; ++e) s += v[j][e] * v[j][e]; }
        s = wave_sum(s);
        const float rstd = rsqrtf(s * (1.f / 1024.f) + EPS);
#pragma unroll
        for (int j = 0; j < 2; ++j) { const int c0 = (lane + 64 * j) * 8; const f32x4 g0 = *(const f32x4*)(g + c0), g1 = *(const f32x4*)(g + c0 + 4);
            const f32x4 y0 = (f32x4){v[j][0], v[j][1], v[j][2], v[j][3]} * rstd * g0, y1 = (f32x4){v[j][4], v[j][5], v[j][6], v[j][7]} * rstd * g1;
            if (hout) { u32x4 o; o.x = pk2(y0[0], y0[1]); o.y = pk2(y0[2], y0[3]); o.z = pk2(y1[0], y1[1]); o.w = pk2(y1[2], y1[3]); *(u32x4*)(hout + (size_t)r * 1024 + c0) = o; }
            else { *(f32x4*)(fout + (size_t)r * 1024 + c0) = y0; *(f32x4*)(fout + (size_t)r * 1024 + c0 + 4) = y1; } }
    }
}

DI void gemm_accum(f32x4 (&acc)[4][4], const bf16_t* __restrict__ A, int lda, const bf16_t* __restrict__ B, int ldb, int K, unsigned char* smem) {
    const int tid = get_tid(), lane = tid & 63, w = tid >> 6, wr = w >> 1, wc = w & 1, l15 = lane & 15, quad = lane >> 4;
    bf16_t* As = (bf16_t*)smem;
    bf16_t* Bs = As + 2 * 256 * 80;
    const int arow = tid >> 3, ach = tid & 7;
    const int brow = (arow & ~31) + 16 * ((arow >> 2) & 1) + 4 * ((arow >> 3) & 3) + (arow & 3);
    const bf16_t* ap = A + (size_t)arow * lda + ach * 8;
    const bf16_t* bp = B + (size_t)arow * ldb + ach * 8;
    u32x4 ra[4], rb[2];
#pragma unroll
    for (int i = 0; i < 4; ++i) ra[i] = *(const u32x4*)(ap + (size_t)(64 * i) * lda);
#pragma unroll
    for (int i = 0; i < 2; ++i) rb[i] = *(const u32x4*)(bp + (size_t)(64 * i) * ldb);
    __syncthreads();
#pragma unroll
    for (int i = 0; i < 4; ++i) *(u32x4*)(As + (arow + 64 * i) * 80 + ach * 8) = ra[i];
#pragma unroll
    for (int i = 0; i < 2; ++i) *(u32x4*)(Bs + (brow + 64 * i) * 80 + ach * 8) = rb[i];
    __syncthreads();
    const int nk = K >> 6;
    for (int kt = 0; kt < nk; ++kt) {
        const int cur = kt & 1;
        const bool more = (kt + 1 < nk);
        { const int nk_ = more ? kt + 1 : kt;
#pragma unroll
            for (int i = 0; i < 4; ++i) ra[i] = *(const u32x4*)(ap + (size_t)(64 * i) * lda + nk_ * 64);
#pragma unroll
            for (int i = 0; i < 2; ++i) rb[i] = *(const u32x4*)(bp + (size_t)(64 * i) * ldb + nk_ * 64);
        }
        __builtin_amdgcn_sched_barrier(0);
        const bf16_t* Ac = As + cur * 256 * 80 + (wr * 64 + l15) * 80 + quad * 8;
        const bf16_t* Bc = Bs + cur * 128 * 80 + (wc * 64 + l15) * 80 + quad * 8;
#pragma unroll
        for (int s = 0; s < 2; ++s) {
            bf16x8 af[4], bfr[4];
#pragma unroll
            for (int mi = 0; mi < 4; ++mi) af[mi] = *(const bf16x8*)(Ac + mi * 16 * 80 + s * 32);
#pragma unroll
            for (int ni = 0; ni < 4; ++ni) bfr[ni] = *(const bf16x8*)(Bc + ni * 16 * 80 + s * 32);
#pragma unroll
            for (int mi = 0; mi < 4; ++mi)
#pragma unroll
                for (int ni = 0; ni < 4; ++ni) acc[mi][ni] = mfma16(bfr[ni], af[mi], acc[mi][ni]);
        }
        if (more) {
#pragma unroll
            for (int i = 0; i < 4; ++i) *(u32x4*)(As + (cur ^ 1) * 256 * 80 + (arow + 64 * i) * 80 + ach * 8) = ra[i];
#pragma unroll
            for (int i = 0; i < 2; ++i) *(u32x4*)(Bs + (cur ^ 1) * 128 * 80 + (brow + 64 * i) * 80 + ach * 8) = rb[i];
        }
        __syncthreads();
    }
}
DI void zero_acc(f32x4 (&acc)[4][4]) {
#pragma unroll
    for (int i = 0; i < 4; ++i)
#pragma unroll
        for (int j = 0; j < 4; ++j) acc[i][j] = (f32x4){0.f, 0.f, 0.f, 0.f};
}
DI int vt_total(int MT, int NT) { return (MT / 4) * ((NT + 7) >> 3) * 32; }
DI bool vt_map(int v, int MT, int NT, int& mt, int& nt) {
    const int ncc = (NT + 7) >> 3; const int c = v >> 5, within = v & 31; const int cr = c / ncc, cn = c % ncc;
    mt = cr * 4 + (within & 3); nt = cn * 8 + (within >> 2); return nt < NT && mt < MT;
}
DI int vt_index(int it) { const int G = gridDim.x, b = blockIdx.x; if ((G & 7) == 0) return it * G + (b & 7) * (G >> 3) + (b >> 3); return it * G + b; }

template <int MODE>
DI void gemm_phase(const bf16_t* A, int lda, const bf16_t* Bt, int K, int M, int N, const Params& P, int hb, const float* resid, unsigned char* smem, int do_store = 1) {
    const int MT = M / 256, NT = N / 128, total = vt_total(MT, NT);
    const int tid = get_tid(), lane = tid & 63, w = tid >> 6, wr = w >> 1, wc = w & 1, l15 = lane & 15, quad = lane >> 4;
    bf16_t* proj = (bf16_t*)(P.ws + WS_PROJ);
    float* ag = (float*)(P.ws + WS_AG);
    for (int it = 0;; ++it) {
        const int v = vt_index(it); if (v >= total) break;
        int mt, nt; if (!vt_map(v, MT, NT, mt, nt)) continue;
        f32x4 acc[4][4]; zero_acc(acc);
        gemm_accum(acc, A + (size_t)mt * 256 * lda, lda, Bt + (size_t)nt * 128 * K, K, K, smem);
        const int rbase = mt * 256 + wr * 64 + l15, cbase = nt * 128 + wc * 64 + quad * 4;
#pragma unroll
        for (int mi = 0; mi < 4; ++mi) {
            const int row = rbase + mi * 16;
            if (MODE == 0) {
                if (nt < 78) {
#pragma unroll
                    for (int ni = 0; ni < 4; ++ni) { u32x2 o; o.x = pk2(acc[mi][ni][0], acc[mi][ni][1]); o.y = pk2(acc[mi][ni][2], acc[mi][ni][3]);
                        *(u32x2*)(proj + (size_t)row * PW + cbase + ni * 16) = o; }
                } else if (wc == 0) {
                    *(f32x4*)(ag + (size_t)row * 16 + quad * 4) = acc[mi][0];
                }
            } else if (MODE == 1 || MODE == 3) {
#pragma unroll
                for (int ni = 0; ni < 4; ++ni) { const size_t off = (size_t)row * 1024 + cbase + ni * 16; const f32x4 r = *(const f32x4*)(resid + off); if (do_store) *(f32x4*)(P.out + off) = r + acc[mi][ni]; }
            } else if (MODE == 2) {
                bf16_t* hid = proj;
#pragma unroll
                for (int nj = 0; nj < 2; ++nj) { const f32x4 g = acc[mi][2 * nj], u = acc[mi][2 * nj + 1]; float y[4];
#pragma unroll
                    for (int e = 0; e < 4; ++e) y[e] = g[e] * sigmoidf_(g[e]) * u[e];
                    const int hc = (nt * 128 + wc * 64 + nj * 32) / 2 + quad * 4;
                    u32x2 o; o.x = pk2(y[0], y[1]); o.y = pk2(y[2], y[3]); *(u32x2*)(hid + (size_t)row * DFF + hc) = o; }
            }
        }
    }
}

namespace pg8 {
#define PG8_LAS __attribute__((address_space(3)))
constexpr int BM = 256, BK = 64, HALF = 128, HTB = HALF * BK * 2  , STAGE_BYTES = 8 * HTB, NXCD = 8, WGM = 8;

__host__ __device__ __forceinline__ int lds_byte(int r, int c) { const int st = (r >> 4) * 2 + (c >> 5), rr = r & 15, cc = c & 31, ob = rr * 64 + cc * 2; return st * 1024 + (ob ^ (((ob >> 9) & 1) << 5)); }
__host__ __device__ __forceinline__ void stage_rc(int b, int& R, int& C) { const int st = b / 1024, sb = b % 1024, swz = sb ^ (((sb >> 9) & 1) << 5); R = (st >> 1) * 16 + swz / 64; C = (st & 1) * 32 + (swz % 64) / 2; }
__host__ __device__ __forceinline__ int perm32(int rho) { const int n = rho >> 4, i = rho & 15; return 8 * (i >> 2) + 4 * n + (i & 3); }

struct Unit { int pm, pn; };
struct Gemm { const bf16_t* A; const bf16_t* Bt; int M, N, K; };

struct StaticOrder {
    int nM, nN, nwg, G, c;
    __host__ __device__ void init(int M, int N, int G_, int c_) { nM = M / BM; nN = N / BM; nwg = nM * nN; G = G_; c = c_; }
    __host__ __device__ bool next(int i, Unit& u) const {
        const long L = (long)i * G + c; if (L >= nwg) return false;
        int wgid = (int)L; { const int q = nwg / NXCD, r = nwg % NXCD, xcd = wgid % NXCD, off = wgid / NXCD; wgid = (xcd < r ? xcd * (q + 1) : r * (q + 1) + (xcd - r) * q) + off; }
        const int nig = WGM * nN, gid = wgid / nig, fm = gid * WGM, gsz = (nM - fm) < WGM ? (nM - fm) : WGM;
        u.pm = fm + ((wgid % nig) % gsz); u.pn = (wgid % nig) / gsz; return true;
    }
    __device__ __forceinline__ void a_ready(const Unit&) const {}
    __device__ __forceinline__ void done(const Unit&) const {}
};
template <class Epi, class Sched, bool ALIGN_EPI = false, bool SP2 = false>
__device__ __forceinline__ void gemm_phase(PG8_LAS unsigned char* lds, const Gemm g, const Sched& S, const Epi& E) {
    const int tid = get_tid(), wid = __builtin_amdgcn_readfirstlane(tid >> 6), lane = tid & 63, wr = wid >> 2, wc = wid & 3, fr = lane & 15, fq = lane >> 4;
    const int K = g.K, nt = K / BK;
    unsigned voffA[2], voffB[2];
#pragma unroll
    for (int i = 0; i < 2; ++i) { int R, C; stage_rc(tid * 16 + i * 8192, R, C); const int Rb = Epi::PERM ? ((R & ~31) + perm32(R & 31)) : R;
        voffA[i] = (unsigned)(R * K + C) * 2u; voffB[i] = (unsigned)(Rb * K + C) * 2u; }
    const size_t kstep = (size_t)(BK * 2);
    const size_t hstep = (size_t)HALF * K * 2;
    const size_t tstep = 2 * hstep;
    const unsigned ldsw = (unsigned)wid * 1024u;
    const int aoff = lds_byte(wr * 64 + fr, fq * 8), boff = lds_byte(wc * 32 + fr, fq * 8);
#define PG8_SA(b, h) (((b) * 2 + (h)) * HTB)
#define PG8_SB(b, h) ((4 + (b) * 2 + (h)) * HTB)
#define PG8_STAGE(bufoff, gbase, voff) do { _Pragma("unroll") for (int _i = 0; _i < 2; ++_i) \
        __builtin_amdgcn_global_load_lds((const unsigned*)((const char*)(gbase) + (voff)[_i]), (PG8_LAS unsigned*)(lds + (bufoff) + ldsw + _i * 8192), 16, 0, 0); } while (0)
#define PG8_LDA(dst, b, h) do { _Pragma("unroll") for (int m = 0; m < 4; ++m) _Pragma("unroll") for (int k = 0; k < 2; ++k) dst[m][k] = *(const PG8_LAS bf16x8*)(lds + PG8_SA(b, h) + aoff + m * 2048 + k * 1024); } while (0)
#define PG8_LDB(dst, b, h) do { _Pragma("unroll") for (int n = 0; n < 2; ++n) _Pragma("unroll") for (int k = 0; k < 2; ++k) dst[n][k] = *(const PG8_LAS bf16x8*)(lds + PG8_SB(b, h) + boff + n * 2048 + k * 1024); } while (0)
#define PG8_MMA(ai, bj, At, Bt) do { __builtin_amdgcn_s_setprio(1); _Pragma("unroll") for (int m = 0; m < 4; ++m) _Pragma("unroll") for (int n = 0; n < 2; ++n) _Pragma("unroll") for (int k = 0; k < 2; ++k) \
        acc[ai][bj][m][n] = __builtin_amdgcn_mfma_f32_16x16x32_bf16(Bt[n][k], At[m][k], acc[ai][bj][m][n], 0, 0, 0); __builtin_amdgcn_s_setprio(0); } while (0)
#define PG8_WAIT_V(n) asm volatile("s_waitcnt vmcnt(" #n ")" ::: "memory")
#define PG8_WAIT_L(n) asm volatile("s_waitcnt lgkmcnt(" #n ")" ::: "memory")
#define PG8_BAR __builtin_amdgcn_s_barrier()
#define PG8_SCHED __builtin_amdgcn_sched_barrier(0)
    Unit cur, nxt; int ui = 0;
    if (!S.next(0, cur)) return;
    f32x4 acc[2][2][4][2];
#pragma unroll
    for (int a = 0; a < 2; ++a)
#pragma unroll
        for (int b = 0; b < 2; ++b)
#pragma unroll
            for (int m = 0; m < 4; ++m)
#pragma unroll
                for (int n = 0; n < 2; ++n) acc[a][b][m][n] = (f32x4){0.f, 0.f, 0.f, 0.f};
    bf16x8 At[4][2], B0[2][2], B1[2][2];
    const char* cA = (const char*)g.A + (size_t)cur.pm * tstep; const char* cB = (const char*)g.Bt + (size_t)cur.pn * tstep;
    S.a_ready(cur);
    if constexpr (SP2) {
        PG8_STAGE(PG8_SB(0, 0), cB, voffB); PG8_STAGE(PG8_SB(0, 1), cB + hstep, voffB); PG8_STAGE(PG8_SA(0, 0), cA, voffA); PG8_STAGE(PG8_SA(0, 1), cA + hstep, voffA);
        if (wr == 1) PG8_BAR;
        PG8_WAIT_V(2); PG8_BAR;
        PG8_STAGE(PG8_SB(1, 0), cB + kstep, voffB); PG8_STAGE(PG8_SA(1, 0), cA + kstep, voffA); PG8_STAGE(PG8_SB(1, 1), cB + hstep + kstep, voffB);
        PG8_WAIT_V(6); PG8_BAR;
    } else {
        PG8_STAGE(PG8_SB(0, 0), cB, voffB); PG8_STAGE(PG8_SA(0, 0), cA, voffA); PG8_STAGE(PG8_SB(0, 1), cB + hstep, voffB); PG8_STAGE(PG8_SA(0, 1), cA + hstep, voffA);
        if (wr == 1) PG8_BAR;
        PG8_WAIT_V(4); PG8_BAR;
        PG8_STAGE(PG8_SB(1, 0), cB + kstep, voffB); PG8_STAGE(PG8_SA(1, 0), cA + kstep, voffA); PG8_STAGE(PG8_SB(1, 1), cB + hstep + kstep, voffB);
        PG8_WAIT_V(6); PG8_BAR;
    }
    for (;;) {
        const bool has_next = S.next(ui + 1, nxt);
        const char* nA = has_next ? (const char*)g.A + (size_t)nxt.pm * tstep : cA; const char* nB = has_next ? (const char*)g.Bt + (size_t)nxt.pn * tstep : cB;
        for (int t = 0; t < nt; t += 2) {
            const bool last = (t == nt - 2);
            const char* a1 = cA + (size_t)(t + 1) * kstep;
            const char* a2 = last ? nA : cA + (size_t)(t + 2) * kstep; const char* b2 = last ? nB : cB + (size_t)(t + 2) * kstep;
            const char* a3 = a2 + kstep; const char* b3 = b2 + kstep;
            if (last && has_next) S.a_ready(nxt);
            if constexpr (SP2) {
            PG8_LDB(B0, 0, 0); PG8_LDB(B1, 0, 1); PG8_SCHED; PG8_LDA(At, 0, 0); PG8_STAGE(PG8_SA(1, 1), a1 + hstep, voffA);
            PG8_WAIT_V(8); PG8_WAIT_L(0); PG8_BAR; PG8_MMA(0, 0, At, B0); PG8_MMA(0, 1, At, B1); PG8_BAR; PG8_SCHED;
            PG8_LDA(At, 0, 1); PG8_STAGE(PG8_SB(0, 0), b2, voffB); PG8_STAGE(PG8_SB(0, 1), b2 + hstep, voffB); PG8_STAGE(PG8_SA(0, 0), a2, voffA);
            PG8_WAIT_V(8); PG8_WAIT_L(0); PG8_BAR; PG8_MMA(1, 0, At, B0); PG8_MMA(1, 1, At, B1); PG8_BAR; PG8_SCHED;
            PG8_LDB(B0, 1, 0); PG8_LDB(B1, 1, 1); PG8_SCHED; PG8_LDA(At, 1, 0); PG8_STAGE(PG8_SA(0, 1), a2 + hstep, voffA);
            PG8_WAIT_V(8); PG8_WAIT_L(0); PG8_BAR; PG8_MMA(0, 0, At, B0); PG8_MMA(0, 1, At, B1); PG8_BAR; PG8_SCHED;
            PG8_LDA(At, 1, 1); PG8_STAGE(PG8_SB(1, 0), b3, voffB); PG8_STAGE(PG8_SB(1, 1), b3 + hstep, voffB); PG8_STAGE(PG8_SA(1, 0), a3, voffA);
            PG8_WAIT_V(8); PG8_WAIT_L(0); PG8_BAR; PG8_MMA(1, 0, At, B0); PG8_MMA(1, 1, At, B1); PG8_BAR; PG8_SCHED;
            } else {
            PG8_LDB(B0, 0, 0); PG8_SCHED; PG8_LDA(At, 0, 0); PG8_STAGE(PG8_SA(1, 1), a1 + hstep, voffA);
            PG8_WAIT_L(8); PG8_BAR; PG8_WAIT_L(0); PG8_MMA(0, 0, At, B0); PG8_BAR; PG8_SCHED;
            PG8_LDB(B1, 0, 1); PG8_STAGE(PG8_SB(0, 0), b2, voffB);
            PG8_BAR; PG8_WAIT_L(0); PG8_MMA(0, 1, At, B1); PG8_BAR;
            PG8_LDA(At, 0, 1); PG8_STAGE(PG8_SA(0, 0), a2, voffA);
            PG8_BAR; PG8_WAIT_L(0); PG8_MMA(1, 0, At, B0); PG8_BAR; PG8_SCHED;
            PG8_STAGE(PG8_SB(0, 1), b2 + hstep, voffB);
            PG8_WAIT_V(6); PG8_BAR; PG8_MMA(1, 1, At, B1); PG8_BAR;
            PG8_LDB(B0, 1, 0); PG8_SCHED; PG8_LDA(At, 1, 0); PG8_STAGE(PG8_SA(0, 1), a2 + hstep, voffA);
            PG8_WAIT_L(8); PG8_BAR; PG8_WAIT_L(0); PG8_MMA(0, 0, At, B0); PG8_BAR; PG8_SCHED;
            PG8_LDB(B1, 1, 1); PG8_STAGE(PG8_SB(1, 0), b3, voffB);
            PG8_BAR; PG8_WAIT_L(0); PG8_MMA(0, 1, At, B1); PG8_BAR;
            PG8_LDA(At, 1, 1); PG8_STAGE(PG8_SA(1, 0), a3, voffA);
            PG8_BAR; PG8_WAIT_L(0); PG8_MMA(1, 0, At, B0); PG8_BAR; PG8_SCHED;
            PG8_STAGE(PG8_SB(1, 1), b3 + hstep, voffB);
            PG8_WAIT_V(6); PG8_BAR; PG8_MMA(1, 1, At, B1); PG8_BAR;
            }
        }
        if constexpr (ALIGN_EPI) { if (wr == 0) PG8_BAR; }
        if constexpr (!Epi::AFTER_DRAIN) { E(acc, cur, wr, wc, fr, fq); S.done(cur); }
        if (!has_next) break;
#pragma unroll
        for (int a = 0; a < 2; ++a)
#pragma unroll
            for (int b = 0; b < 2; ++b)
#pragma unroll
                for (int m = 0; m < 4; ++m)
#pragma unroll
                    for (int n = 0; n < 2; ++n) acc[a][b][m][n] = (f32x4){0.f, 0.f, 0.f, 0.f};
        cur = nxt; cA = nA; cB = nB; ++ui;
        if constexpr (ALIGN_EPI) { if (wr == 1) PG8_BAR; }
    }
    PG8_WAIT_V(0);
    if constexpr (!ALIGN_EPI) { if (wr == 0) PG8_BAR; }
    PG8_BAR;
    if constexpr (Epi::AFTER_DRAIN) { E.fused(acc, cur, wr, wc, fr, fq, lds, wid, lane); S.done(cur); }
#undef PG8_SA
#undef PG8_SB
#undef PG8_STAGE
#undef PG8_LDA
#undef PG8_LDB
#undef PG8_MMA
#undef PG8_WAIT_V
#undef PG8_WAIT_L
#undef PG8_BAR
#undef PG8_SCHED
}
}


struct EpiInProj {
    static constexpr bool PERM = true, AFTER_DRAIN = false;
    bf16_t* proj; float* ag;
    __device__ __forceinline__ void operator()(const f32x4 (&acc)[2][2][4][2], const pg8::Unit& u, int wr, int wc, int fr, int fq) const {
#pragma unroll
        for (int ai = 0; ai < 2; ++ai)
#pragma unroll
            for (int m = 0; m < 4; ++m) { const int row = u.pm * 256 + ai * 128 + wr * 64 + m * 16 + fr;
#pragma unroll
                for (int bj = 0; bj < 2; ++bj) { const int col = u.pn * 256 + bj * 128 + wc * 32 + fq * 8; const f32x4 v0 = acc[ai][bj][m][0], v1 = acc[ai][bj][m][1];
                    if (col < C_GL) { u32x4 o; o.x = pk2(v0[0], v0[1]); o.y = pk2(v0[2], v0[3]); o.z = pk2(v1[0], v1[1]); o.w = pk2(v1[2], v1[3]); *(u32x4*)(proj + (size_t)row * PW + col) = o; }
                    else if (col < 9984) {
                        u32x2 o; o.x = q8x4(sigmoidf_(v0[0]), sigmoidf_(v0[1]), sigmoidf_(v0[2]), sigmoidf_(v0[3])); o.y = q8x4(sigmoidf_(v1[0]), sigmoidf_(v1[1]), sigmoidf_(v1[2]), sigmoidf_(v1[3]));
                        *(u32x2*)((unsigned char*)proj + (size_t)row * (PW * 2) + GATE_BYTE0 + (col - C_GL)) = o; }
                    else if (col < 10000) { *(f32x4*)(ag + (size_t)row * 16 + (col - 9984)) = v0; *(f32x4*)(ag + (size_t)row * 16 + (col - 9984) + 4) = v1; } } }
    }
};
struct EpiResid {
    static constexpr bool PERM = true, AFTER_DRAIN = false;
    const float* resid_f; const bf16_t* resid_b; bf16_t* xout; int do_store;
    __device__ __forceinline__ void operator()(const f32x4 (&acc)[2][2][4][2], const pg8::Unit& u, int wr, int wc, int fr, int fq) const {
#pragma unroll
        for (int ai = 0; ai < 2; ++ai)
#pragma unroll
            for (int m = 0; m < 4; ++m) { const int row = u.pm * 256 + ai * 128 + wr * 64 + m * 16 + fr;
#pragma unroll
                for (int bj = 0; bj < 2; ++bj) { const size_t off = (size_t)row * 1024 + u.pn * 256 + bj * 128 + wc * 32 + fq * 8;
                    f32x4 r0, r1;
                    if (resid_f) { r0 = *(const f32x4*)(resid_f + off); r1 = *(const f32x4*)(resid_f + off + 4); }
                    else { const u32x4 q = *(const u32x4*)(resid_b + off); r0 = (f32x4){lo_f(q.x), hi_f(q.x), lo_f(q.y), hi_f(q.y)}; r1 = (f32x4){lo_f(q.z), hi_f(q.z), lo_f(q.w), hi_f(q.w)}; }
                    r0 += acc[ai][bj][m][0]; r1 += acc[ai][bj][m][1];
                    u32x4 o; o.x = pk2(r0[0], r0[1]); o.y = pk2(r0[2], r0[3]); o.z = pk2(r1[0], r1[1]); o.w = pk2(r1[2], r1[3]);
                    if (do_store) *(u32x4*)(xout + off) = o; } }
    }
};
struct EpiSwiglu {
    static constexpr bool PERM = true, AFTER_DRAIN = false;
    bf16_t* hid;
    __device__ __forceinline__ void operator()(const f32x4 (&acc)[2][2][4][2], const pg8::Unit& u, int wr, int wc, int fr, int fq) const {
#pragma unroll
        for (int ai = 0; ai < 2; ++ai)
#pragma unroll
            for (int m = 0; m < 4; ++m) { const int row = u.pm * 256 + ai * 128 + wr * 64 + m * 16 + fr;
                float y[8];
#pragma unroll
                for (int n = 0; n < 2; ++n) { const f32x4 g = acc[ai][0][m][n], up = acc[ai][1][m][n];
#pragma unroll
                    for (int e = 0; e < 4; ++e) y[4 * n + e] = g[e] * sigmoidf_(g[e]) * up[e]; }
                u32x4 o; o.x = pk2(y[0], y[1]); o.y = pk2(y[2], y[3]); o.z = pk2(y[4], y[5]); o.w = pk2(y[6], y[7]);
                *(u32x4*)(hid + (size_t)row * DFF + u.pn * 128 + wc * 32 + fq * 8) = o; }
    }
};
template <class Epi>
DI void pg8_run(const bf16_t* A, const bf16_t* Bt, int M, int N, int K, const Epi& E, unsigned char* smem) {
    pg8::Gemm g{A, Bt, M, N, K}; pg8::StaticOrder S; S.init(M, N, (int)gridDim.x, (int)blockIdx.x);
    pg8::gemm_phase<Epi, pg8::StaticOrder, true, true>((LAS unsigned char*)smem, g, S, E);
}

DI void merge_phase(const Params& P, int layer, int hb, unsigned char* smem) {
    const int MT = HALF_T / 256, NT = 8, total = vt_total(MT, NT);
    const int tid = get_tid(), lane = tid & 63, w = tid >> 6, wr = w >> 1, wc = w & 1, l15 = lane & 15, quad = lane >> 4;
    const bf16_t* proj = (const bf16_t*)(P.ws + WS_PROJ);
    const bf16_t* wup = (const bf16_t*)(P.ws + WS_W + layer * SZ_WLAYER + SZ_WIN);
    bf16_t* merged = (bf16_t*)(P.ws + WS_H) + (size_t)hb * HALF_T * 1024;
    if (__builtin_amdgcn_readfirstlane(w) >= 4) __builtin_amdgcn_s_setprio(1);
    for (int it = 0;; ++it) {
        const int v = vt_index(it); if (v >= total) break;
        int mt, nt; if (!vt_map(v, MT, NT, mt, nt)) continue;
        f32x4 tot[4][4]; zero_acc(tot);
        const int rbase = mt * 256 + wr * 64 + l15, cbase = nt * 128 + wc * 64 + quad * 8;
#pragma unroll 1
        for (int g = 0; g < 4; ++g) {
            f32x4 acc[4][4]; zero_acc(acc);
            const int ycol = g == 0 ? C_AO : (g == 1 ? C_BQ : (g == 2 ? C_CQ : C_DQ));
            gemm_accum(acc, proj + (size_t)mt * 256 * PW + ycol, PW, wup + (size_t)g * 1024 * 512 + (size_t)nt * 128 * 512, 512, 512, smem);
#pragma unroll
            for (int mi = 0; mi < 4; ++mi)
#pragma unroll
                for (int p = 0; p < 2; ++p) {
                    const u32x2 gb = *(const u32x2*)((const unsigned char*)proj + (size_t)(rbase + mi * 16) * (PW * 2) + GATE_BYTE0 + g * 1024 + cbase + p * 32);
                    tot[mi][2 * p][0] += ub0(gb.x) * acc[mi][2 * p][0]; tot[mi][2 * p][1] += ub1(gb.x) * acc[mi][2 * p][1];
                    tot[mi][2 * p][2] += ub2(gb.x) * acc[mi][2 * p][2]; tot[mi][2 * p][3] += ub3(gb.x) * acc[mi][2 * p][3];
                    tot[mi][2 * p + 1][0] += ub0(gb.y) * acc[mi][2 * p + 1][0]; tot[mi][2 * p + 1][1] += ub1(gb.y) * acc[mi][2 * p + 1][1];
                    tot[mi][2 * p + 1][2] += ub2(gb.y) * acc[mi][2 * p + 1][2]; tot[mi][2 * p + 1][3] += ub3(gb.y) * acc[mi][2 * p + 1][3];
                }
        }
#pragma unroll
        for (int mi = 0; mi < 4; ++mi)
#pragma unroll
            for (int p = 0; p < 2; ++p) { u32x4 o; o.x = pk2(tot[mi][2 * p][0], tot[mi][2 * p][1]); o.y = pk2(tot[mi][2 * p][2], tot[mi][2 * p][3]);
                o.z = pk2(tot[mi][2 * p + 1][0], tot[mi][2 * p + 1][1]); o.w = pk2(tot[mi][2 * p + 1][2], tot[mi][2 * p + 1][3]);
                *(u32x4*)(merged + (size_t)(rbase + mi * 16) * 1024 + cbase + p * 32) = o; }
    }
    __builtin_amdgcn_s_setprio(0);
}

DI void prep_b(const Params& P, int layer) {
    bf16_t* proj = (bf16_t*)(P.ws + WS_PROJ);
    const float* qg = P.in[6] + layer * 64; const float* kg = P.in[7] + layer * 64;
    const int gtid = blockIdx.x * 512 + get_tid(), nth = gridDim.x * 512;
    for (int item = gtid; item < HALF_T * 10; item += nth) {
        const int tok = item / 10, v = item % 10;
        const int col = v < 8 ? C_BQ + v * 64 : C_BK + (v - 8) * 64;
        const float* g = v < 8 ? qg : kg;
        bf16_t* p = proj + (size_t)tok * PW + col;
        float x[64];
#pragma unroll
        for (int c = 0; c < 8; ++c) { const u32x4 u = *(const u32x4*)(p + c * 8);
            x[c * 8 + 0] = lo_f(u.x); x[c * 8 + 1] = hi_f(u.x); x[c * 8 + 2] = lo_f(u.y); x[c * 8 + 3] = hi_f(u.y);
            x[c * 8 + 4] = lo_f(u.z); x[c * 8 + 5] = hi_f(u.z); x[c * 8 + 6] = lo_f(u.w); x[c * 8 + 7] = hi_f(u.w); }
        float ss = 0.f;
#pragma unroll
        for (int i = 0; i < 64; ++i) ss += x[i] * x[i];
        const float rstd = rsqrtf(ss * (1.f / 64.f) + EPS);
#pragma unroll
        for (int i = 0; i < 64; ++i) x[i] = x[i] * rstd * g[i];
        const int pos = tok & (SEQ - 1); const float frow = (float)(pos >> 6), fcol = (float)(pos & 63);
#pragma unroll
        for (int i = 0; i < 16; ++i) {
            const float inv = exp2f(-(float)i * (13.287712379549449f / 16.f));
            float ar = frow * inv * 0.15915494309189535f, ac = fcol * inv * 0.15915494309189535f;
            ar -= floorf(ar); ac -= floorf(ac);
            const float cr = __builtin_amdgcn_cosf(ar), sr = __builtin_amdgcn_sinf(ar), cc = __builtin_amdgcn_cosf(ac), sc = __builtin_amdgcn_sinf(ac);
            float a = x[i], b = x[i + 16]; x[i] = a * cr - b * sr; x[i + 16] = b * cr + a * sr;
            a = x[32 + i]; b = x[48 + i]; x[32 + i] = a * cc - b * sc; x[48 + i] = b * cc + a * sc;
        }
        const float sc_ = v < 8 ? 0.125f * LOG2E : 1.f;
#pragma unroll
        for (int c = 0; c < 8; ++c) { u32x4 u; u.x = pk2(x[c * 8] * sc_, x[c * 8 + 1] * sc_); u.y = pk2(x[c * 8 + 2] * sc_, x[c * 8 + 3] * sc_);
            u.z = pk2(x[c * 8 + 4] * sc_, x[c * 8 + 5] * sc_); u.w = pk2(x[c * 8 + 6] * sc_, x[c * 8 + 7] * sc_); *(u32x4*)(p + c * 8) = u; }
    }
}

DI void attn_b_unit(const Params& P, int unit, unsigned char* smem, int do_store = 1) {
    const int tid = get_tid(), lane = tid & 63, w = tid >> 6, l15 = lane & 15, quad = lane >> 4;
    const int wsc = __builtin_amdgcn_readfirstlane(w);
    const int qb = unit & 15, hq = (unit >> 4) & 7, b = unit >> 7, kvh = hq >> 2;
    if (wsc >= 4) __builtin_amdgcn_s_setprio(1);
    bf16_t* base = (bf16_t*)(P.ws + WS_PROJ) + (size_t)b * SEQ * PW;
    const int qrow0 = qb * 256 + w * 32;
    bf16x8 qf[2][2];
#pragma unroll
    for (int qt = 0; qt < 2; ++qt)
#pragma unroll
        for (int s = 0; s < 2; ++s) qf[qt][s] = *(const bf16x8*)(base + (size_t)(qrow0 + qt * 16 + l15) * PW + C_BQ + hq * 64 + s * 32 + quad * 8);
    bf16_t* Ks = (bf16_t*)smem;
    bf16_t* Vs = Ks + 2 * 64 * 80;
    const int lrow = tid >> 3, lch = tid & 7;
    const bf16_t* kp = base + (size_t)lrow * PW + C_BK + kvh * 64 + lch * 8;
    const bf16_t* vp = base + (size_t)lrow * PW + C_BV + kvh * 64 + lch * 8;
    u32x4 rk = *(const u32x4*)kp, rv = *(const u32x4*)vp;
    __syncthreads();
    *(u32x4*)(Ks + lrow * 80 + lch * 8) = rk; *(u32x4*)(Vs + lrow * 80 + lch * 8) = rv;
    __syncthreads();
    f32x4 o[2][4]; float m[2], l[2];
#pragma unroll
    for (int qt = 0; qt < 2; ++qt) { m[qt] = -1e30f; l[qt] = 0.f;
#pragma unroll
        for (int d = 0; d < 4; ++d) o[qt][d] = (f32x4){0.f, 0.f, 0.f, 0.f}; }
    constexpr int NKT = SEQ / 64;
    bf16x8 pb[2][2];
#pragma unroll
    for (int kg = 0; kg < 2; ++kg)
#pragma unroll
        for (int qt = 0; qt < 2; ++qt) pb[kg][qt] = (bf16x8){0, 0, 0, 0, 0, 0, 0, 0};
    f32x4 st[4][2];
    auto do_S = [&](const bf16_t* Kc) {
#pragma unroll
        for (int k16 = 0; k16 < 4; ++k16) {
            const bf16x8 k0 = *(const bf16x8*)(Kc + (k16 * 16 + l15) * 80 + quad * 8), k1 = *(const bf16x8*)(Kc + (k16 * 16 + l15) * 80 + 32 + quad * 8);
#pragma unroll
            for (int qt = 0; qt < 2; ++qt) { f32x4 z = (f32x4){0.f, 0.f, 0.f, 0.f}; z = mfma16(k0, qf[qt][0], z); st[k16][qt] = mfma16(k1, qf[qt][1], z); }
        }
    };
    auto do_PV = [&](const unsigned char* Vc) {
#pragma unroll
        for (int kg = 0; kg < 2; ++kg)
#pragma unroll
            for (int d = 0; d < 4; ++d) {
                const unsigned char* a0 = Vc + (kg * 32 + quad * 4 + (l15 >> 2)) * 160 + (d * 16 + (l15 & 3) * 4) * 2;
                const bf16x8 va = tr_pair(a0, a0 + 16 * 160);
#pragma unroll
                for (int qt = 0; qt < 2; ++qt) o[qt][d] = mfma16(va, pb[kg][qt], o[qt][d]);
            }
    };
    auto do_softmax = [&]() {
#pragma unroll
        for (int qt = 0; qt < 2; ++qt) {
            float mx = -1e30f;
#pragma unroll
            for (int k16 = 0; k16 < 4; ++k16)
#pragma unroll
                for (int e = 0; e < 4; ++e) mx = fmaxf(mx, st[k16][qt][e]);
            const float mn = fmaxf(m[qt], quad_max(mx));
            if (__builtin_amdgcn_ballot_w64(mn > m[qt]) != 0ull) {
                const float alpha = fexp2(m[qt] - mn); m[qt] = mn; l[qt] *= alpha;
#pragma unroll
                for (int d = 0; d < 4; ++d) o[qt][d] *= alpha;
            }
            float ps = 0.f;
#pragma unroll
            for (int k16 = 0; k16 < 4; ++k16)
#pragma unroll
                for (int e = 0; e < 4; ++e) { const float p = fexp2(st[k16][qt][e] - mn); st[k16][qt][e] = p; ps += p; }
            l[qt] += ps;
            pb[0][qt] = pack8(st[0][qt], st[1][qt]); pb[1][qt] = pack8(st[2][qt], st[3][qt]);
        }
    };
    int vprev = 0, vcur = 0, vnext = 1;
    if (wsc < 4) {
        for (int kt = 0; kt < NKT; ++kt) {
            const int cur = kt & 1;
            { const int nk_ = kt + 1 < NKT ? kt + 1 : kt; rk = *(const u32x4*)(kp + (size_t)nk_ * 64 * PW); rv = *(const u32x4*)(vp + (size_t)nk_ * 64 * PW); }
            do_S(Ks + cur * 64 * 80);
            do_PV((const unsigned char*)(Vs + vprev * 64 * 80));
            do_softmax();
            { *(u32x4*)(Ks + (cur ^ 1) * 64 * 80 + lrow * 80 + lch * 8) = rk; *(u32x4*)(Vs + vnext * 64 * 80 + lrow * 80 + lch * 8) = rv; }
            vprev = vcur; vcur = vnext; vnext = vnext == 2 ? 0 : vnext + 1;
            __syncthreads();
        }
        do_PV((const unsigned char*)(Vs + vprev * 64 * 80));
    } else {
        for (int kt = 0; kt < NKT; ++kt) {
            const int cur = kt & 1;
            { const int nk_ = kt + 1 < NKT ? kt + 1 : kt; rk = *(const u32x4*)(kp + (size_t)nk_ * 64 * PW); rv = *(const u32x4*)(vp + (size_t)nk_ * 64 * PW); }
            if (kt > 0) do_softmax();
            do_S(Ks + cur * 64 * 80);
            do_PV((const unsigned char*)(Vs + vprev * 64 * 80));
            { *(u32x4*)(Ks + (cur ^ 1) * 64 * 80 + lrow * 80 + lch * 8) = rk; *(u32x4*)(Vs + vnext * 64 * 80 + lrow * 80 + lch * 8) = rv; }
            vprev = vcur; vcur = vnext; vnext = vnext == 2 ? 0 : vnext + 1;
            __syncthreads();
        }
        do_softmax();
        do_PV((const unsigned char*)(Vs + vprev * 64 * 80));
    }
    __builtin_amdgcn_s_setprio(0);
#pragma unroll
    for (int qt = 0; qt < 2; ++qt) {
        const float inv = 1.f / quad_sum(l[qt]);
        bf16_t* op = base + (size_t)(qrow0 + qt * 16 + l15) * PW + C_BQ + hq * 64 + quad * 4;
#pragma unroll
        for (int d = 0; d < 4; ++d) { u32x2 u; u.x = pk2(o[qt][d][0] * inv, o[qt][d][1] * inv); u.y = pk2(o[qt][d][2] * inv, o[qt][d][3] * inv); if (do_store) *(u32x2*)(op + d * 16) = u; }
    }
}

DI bf16x8 scale8(bf16x8 v, float s) {
    const u32x4 u = __builtin_bit_cast(u32x4, v); u32x4 r;
    r.x = pk2(lo_f(u.x) * s, hi_f(u.x) * s); r.y = pk2(lo_f(u.y) * s, hi_f(u.y) * s); r.z = pk2(lo_f(u.z) * s, hi_f(u.z) * s); r.w = pk2(lo_f(u.w) * s, hi_f(u.w) * s);
    return __builtin_bit_cast(bf16x8, r);
}
DI void attn_d_unit(const Params& P, int layer, int unit, unsigned char* smem, int do_store = 1) {
    const int tid = get_tid(), lane = tid & 63, w = tid >> 6, l15 = lane & 15, quad = lane >> 4;
    const int qb = unit & 31, h = (unit >> 5) & 3, b = unit >> 7;
    bf16_t* base = (bf16_t*)(P.ws + WS_PROJ) + (size_t)b * SEQ * PW;
    const int qrow = qb * 128 + w * 16 + l15;
    if (__builtin_amdgcn_readfirstlane(w) >= 4) __builtin_amdgcn_s_setprio(1);
    bf16x8 qf[2][2];
#pragma unroll
    for (int c = 0; c < 2; ++c)
#pragma unroll
        for (int s = 0; s < 2; ++s) qf[c][s] = scale8(*(const bf16x8*)(base + (size_t)qrow * PW + C_DQ + h * 128 + c * 64 + s * 32 + quad * 8), 0.125f * LOG2E);
    bf16_t* Ks = (bf16_t*)smem;
    bf16_t* Vs = Ks + 2 * 64 * 144;
    const int lrow = tid >> 4, lch = tid & 15;
    const bf16_t* kp = base + (size_t)lrow * PW + C_DK + h * 128 + lch * 8;
    const bf16_t* vp = base + (size_t)lrow * PW + C_DV + h * 128 + lch * 8;
    u32x4 rk[2], rv[2];
#pragma unroll
    for (int i = 0; i < 2; ++i) { rk[i] = *(const u32x4*)(kp + (size_t)(32 * i) * PW); rv[i] = *(const u32x4*)(vp + (size_t)(32 * i) * PW); }
    __syncthreads();
#pragma unroll
    for (int i = 0; i < 2; ++i) { *(u32x4*)(Ks + (lrow + 32 * i) * 144 + lch * 8) = rk[i]; *(u32x4*)(Vs + (lrow + 32 * i) * 144 + lch * 8) = rv[i]; }
    __syncthreads();
    f32x4 o[2][8]; float m[2], l[2];
#pragma unroll
    for (int c = 0; c < 2; ++c) { m[c] = -1e30f; l[c] = 0.f;
#pragma unroll
        for (int d = 0; d < 8; ++d) o[c][d] = (f32x4){0.f, 0.f, 0.f, 0.f}; }
    const float slope2 = exp2f(-2.f * (float)(h + 1)) * LOG2E;
    const float dbase = (float)(quad * 4 - qrow);
    constexpr int NKT = SEQ / 64;
    f32x4 st[2][4]; bf16x8 pb[2][2];
#pragma unroll
    for (int c = 0; c < 2; ++c)
#pragma unroll
        for (int kg = 0; kg < 2; ++kg) pb[c][kg] = (bf16x8){0, 0, 0, 0, 0, 0, 0, 0};
    auto do_S = [&](const bf16_t* Kc, int kt) {
#pragma unroll
        for (int c = 0; c < 2; ++c)
#pragma unroll
            for (int k16 = 0; k16 < 4; ++k16) {
                const bf16x8 k0 = *(const bf16x8*)(Kc + (k16 * 16 + l15) * 144 + c * 64 + quad * 8), k1 = *(const bf16x8*)(Kc + (k16 * 16 + l15) * 144 + c * 64 + 32 + quad * 8);
                f32x4 z = (f32x4){0.f, 0.f, 0.f, 0.f}; z = mfma16(k0, qf[c][0], z); z = mfma16(k1, qf[c][1], z);
                const float d0 = dbase + (float)(kt * 64 + k16 * 16);
#pragma unroll
                for (int e = 0; e < 4; ++e) z[e] = z[e] - slope2 * fabsf(d0 + (float)e);
                st[c][k16] = z;
            }
    };
    auto do_softmax = [&]() {
#pragma unroll
        for (int c = 0; c < 2; ++c) {
            float mx = -1e30f;
#pragma unroll
            for (int k16 = 0; k16 < 4; ++k16)
#pragma unroll
                for (int e = 0; e < 4; ++e) mx = fmaxf(mx, st[c][k16][e]);
            const float mn = fmaxf(m[c], quad_max(mx));
            if (__builtin_amdgcn_ballot_w64(mn > m[c]) != 0ull) {
                const float alpha = fexp2(m[c] - mn); m[c] = mn; l[c] *= alpha;
#pragma unroll
                for (int d = 0; d < 8; ++d) o[c][d] *= alpha;
            }
            float ps = 0.f;
#pragma unroll
            for (int k16 = 0; k16 < 4; ++k16)
#pragma unroll
                for (int e = 0; e < 4; ++e) { const float p = fexp2(st[c][k16][e] - mn); st[c][k16][e] = p; ps += p; }
            l[c] += ps;
            pb[c][0] = pack8(st[c][0], st[c][1]); pb[c][1] = pack8(st[c][2], st[c][3]);
        }
    };
    auto do_PV = [&](const unsigned char* Vc) {
#pragma unroll
        for (int kg = 0; kg < 2; ++kg)
#pragma unroll
            for (int d = 0; d < 8; ++d) {
                const unsigned char* a0 = Vc + (kg * 32 + quad * 4 + (l15 >> 2)) * 288 + (d * 16 + (l15 & 3) * 4) * 2;
                const bf16x8 va = tr_pair(a0, a0 + 16 * 288);
                o[0][d] = mfma16(va, pb[0][kg], o[0][d]); o[1][d] = mfma16(va, pb[1][kg], o[1][d]);
            }
    };
    int vprev = 0, vcur = 0, vnext = 1;
#define D_PREFETCH() { const int nk_ = kt + 1 < NKT ? kt + 1 : kt; _Pragma("unroll") for (int i = 0; i < 2; ++i) { rk[i] = *(const u32x4*)(kp + (size_t)(nk_ * 64 + 32 * i) * PW); rv[i] = *(const u32x4*)(vp + (size_t)(nk_ * 64 + 32 * i) * PW); } }
#define D_STAGE() { _Pragma("unroll") for (int i = 0; i < 2; ++i) { *(u32x4*)(Ks + (cur ^ 1) * 64 * 144 + (lrow + 32 * i) * 144 + lch * 8) = rk[i]; *(u32x4*)(Vs + vnext * 64 * 144 + (lrow + 32 * i) * 144 + lch * 8) = rv[i]; } \
                    vprev = vcur; vcur = vnext; vnext = vnext == 2 ? 0 : vnext + 1; }
    if (__builtin_amdgcn_readfirstlane(w) < 4) {
        for (int kt = 0; kt < NKT; ++kt) {
            const int cur = kt & 1;
            D_PREFETCH();
            do_S(Ks + cur * 64 * 144, kt);
            do_PV((const unsigned char*)(Vs + vprev * 64 * 144));
            do_softmax();
            D_STAGE();
            __syncthreads();
        }
        do_PV((const unsigned char*)(Vs + vprev * 64 * 144));
    } else {
        for (int kt = 0; kt < NKT; ++kt) {
            const int cur = kt & 1;
            D_PREFETCH();
            if (kt > 0) do_softmax();
            do_S(Ks + cur * 64 * 144, kt);
            do_PV((const unsigned char*)(Vs + vprev * 64 * 144));
            D_STAGE();
            __syncthreads();
        }
        do_softmax();
        do_PV((const unsigned char*)(Vs + vprev * 64 * 144));
    }
#undef D_PREFETCH
#undef D_STAGE
    __builtin_amdgcn_s_setprio(0);
    const float lam = ((const float*)(P.ws + WS_LAM))[layer];
    const float linit = layer == 0 ? 0.2f : 0.35550906f;
    const float i0 = 1.f / quad_sum(l[0]), i1 = lam / quad_sum(l[1]);
    float ss = 0.f;
#pragma unroll
    for (int d = 0; d < 8; ++d)
#pragma unroll
        for (int e = 0; e < 4; ++e) { const float y = o[0][d][e] * i0 - o[1][d][e] * i1; o[0][d][e] = y; ss += y * y; }
    ss = quad_sum(ss);
    const float rstd = rsqrtf(ss * (1.f / 128.f) + EPS) * (1.f - linit);
    const float* sg = P.in[13] + layer * 128;
    bf16_t* op = base + (size_t)qrow * PW + C_DQ + h * 128 + quad * 4;
#pragma unroll
    for (int d = 0; d < 8; ++d) { const f32x4 g = *(const f32x4*)(sg + d * 16 + quad * 4);
        u32x2 u; u.x = pk2(o[0][d][0] * rstd * g[0], o[0][d][1] * rstd * g[1]); u.y = pk2(o[0][d][2] * rstd * g[2], o[0][d][3] * rstd * g[3]); if (do_store) *(u32x2*)(op + d * 16) = u; }
}

DI void natten_iter(const Params& P, int u, const float* rpb_lds, unsigned char* vls, int do_store = 1) {
    const int tid = get_tid(), lane = tid & 63, h = tid >> 6, l15 = lane & 15, quad = lane >> 4;
    const int cg_ = u & 3, r = (u >> 2) & 63, b = u >> 8;
    const int c0 = cg_ * 16, kc0 = min(max(c0 - 8, 0), 32), rs = min(max(r - 4, 0), 56);
    bf16_t* base = (bf16_t*)(P.ws + WS_PROJ) + (size_t)b * SEQ * PW;
    const int qtok = r * 64 + c0 + l15;
    bf16x8 qf[2];
#pragma unroll
    for (int s = 0; s < 2; ++s) qf[s] = *(const bf16x8*)(base + (size_t)qtok * PW + C_CQ + h * 64 + s * 32 + quad * 8);
    f32x4 st[16];
#pragma unroll
    for (int k16 = 0; k16 < 16; ++k16) {
        const int ktok = (rs + (k16 >> 1)) * 64 + kc0 + (k16 & 1) * 16 + l15;
        const bf16_t* kp = base + (size_t)ktok * PW + C_CK + h * 64 + quad * 8;
        const bf16x8 k0 = *(const bf16x8*)kp, k1 = *(const bf16x8*)(kp + 32);
        f32x4 z = (f32x4){0.f, 0.f, 0.f, 0.f}; z = mfma16(k0, qf[0], z); st[k16] = mfma16(k1, qf[1], z);
    }
    const int c = c0 + l15, cs = min(max(c - 8, 0), 48);
    const float* rp = rpb_lds + h * 465;
    float mx = -1e30f;
#pragma unroll
    for (int k16 = 0; k16 < 16; ++k16) {
        const int kr = rs + (k16 >> 1);
#pragma unroll
        for (int e = 0; e < 4; ++e) {
            const int kc = kc0 + (k16 & 1) * 16 + quad * 4 + e;
            const bool valid = (kc >= cs) && (kc < cs + 16);
            const int idx = valid ? (kr - r + 7) * 31 + (kc - c + 15) : 0;
            const float s = valid ? (st[k16][e] * 0.125f + rp[idx]) * LOG2E : -1e30f;
            st[k16][e] = s; mx = fmaxf(mx, s);
        }
    }
    mx = quad_max(mx);
    float ps = 0.f;
#pragma unroll
    for (int k16 = 0; k16 < 16; ++k16)
#pragma unroll
        for (int e = 0; e < 4; ++e) { const float p = fexp2(st[k16][e] - mx); st[k16][e] = p; ps += p; }
    const float inv = 1.f / quad_sum(ps);
    f32x4 o[4];
#pragma unroll
    for (int d = 0; d < 4; ++d) o[d] = (f32x4){0.f, 0.f, 0.f, 0.f};
    unsigned char* Vw = vls + h * 10240;
    u32x4 rv[8];
#pragma unroll
    for (int i = 0; i < 8; ++i) { const int idx = lane + 64 * i, j = idx >> 3, c8 = idx & 7; const int kk = j;
        const int vtok = (rs + (kk >> 5)) * 64 + kc0 + (kk & 31);
        rv[i] = *(const u32x4*)(base + (size_t)vtok * PW + C_CV + h * 64 + c8 * 8); }
#pragma unroll
    for (int ch = 0; ch < 4; ++ch) {
        __syncthreads();
#pragma unroll
        for (int i = 0; i < 8; ++i) { const int idx = lane + 64 * i, j = idx >> 3, c8 = idx & 7; *(u32x4*)(Vw + j * 160 + c8 * 16) = rv[i]; }
        if (ch < 3) {
#pragma unroll
            for (int i = 0; i < 8; ++i) { const int idx = lane + 64 * i, j = idx >> 3, c8 = idx & 7; const int kk = (ch + 1) * 64 + j;
                const int vtok = (rs + (kk >> 5)) * 64 + kc0 + (kk & 31);
                rv[i] = *(const u32x4*)(base + (size_t)vtok * PW + C_CV + h * 64 + c8 * 8); }
        }
        __syncthreads();
#pragma unroll
        for (int kgl = 0; kgl < 2; ++kgl) {
            const bf16x8 pb = pack8(st[(2 * ch + kgl) * 2], st[(2 * ch + kgl) * 2 + 1]);
#pragma unroll
            for (int d = 0; d < 4; ++d) {
                const unsigned char* a0 = Vw + (kgl * 32 + quad * 4 + (l15 >> 2)) * 160 + (d * 16 + (l15 & 3) * 4) * 2;
                o[d] = mfma16(tr_pair(a0, a0 + 16 * 160), pb, o[d]);
            }
        }
    }
    bf16_t* op = base + (size_t)qtok * PW + C_CQ + h * 64 + quad * 4;
#pragma unroll
    for (int d = 0; d < 4; ++d) { u32x2 uo; uo.x = pk2(o[d][0] * inv, o[d][1] * inv); uo.y = pk2(o[d][2] * inv, o[d][3] * inv); if (do_store) *(u32x2*)(op + d * 16) = uo; }
}

DI float logsigmoidf_(float x) { return fminf(x, 0.f) - __logf(1.f + fexp(-fabsf(x))); }
DI void scan_add2(float e0, float e1, float& o0, float& o1, int lane) {
    float s = e0 + e1;
#pragma unroll
    for (int d = 1; d < 64; d <<= 1) { const float t = __shfl_up(s, d); if (lane >= d) s += t; }
    o1 = s; o0 = s - e1;
}
DI void scan_max2(float e0, float e1, float& o0, float& o1, int lane) {
    float s = fmaxf(e0, e1);
#pragma unroll
    for (int d = 1; d < 64; d <<= 1) { const float t = __shfl_up(s, d); if (lane >= d) s = fmaxf(s, t); }
    float prev = __shfl_up(s, 1); if (lane == 0) prev = -1e30f;
    o0 = fmaxf(prev, e0); o1 = s;
}
DI void mlstm_load_tile(const Params& P, int layer, const bf16_t* base  , int h, int pc, int dir, int which, const float* wts, bf16_t* dst) {
    const int tid = get_tid(), gch = tid & 15, pl0 = tid >> 4;
    if (which == 2) {
        u32x4 v[4];
#pragma unroll
        for (int i = 0; i < 4; ++i) v[i] = *(const u32x4*)(base + (size_t)(pc * 128 + pl0 + 32 * i) * PW + C_AV + h * 128 + gch * 8);
#pragma unroll
        for (int i = 0; i < 4; ++i) { const int pl = pl0 + 32 * i, tl = dir ? 127 - pl : pl; *(u32x4*)(dst + tl * 144 + gch * 8) = v[i]; }
        return;
    }
    const int col = (which ? C_AK : C_AQ) + h * 128 + gch * 8;
    const float* cw = P.in[3] + layer * 3072 + (which ? 512 : 0) + h * 128 + gch * 8;
    const u32x4 z4 = (u32x4){0u, 0u, 0u, 0u};
    u32x4 x0[4], x1[4], x2[4];
#pragma unroll
    for (int i = 0; i < 4; ++i) {
        const int pos = pc * 128 + pl0 + 32 * i;
        x0[i] = pos > 0 ? *(const u32x4*)(base + (size_t)(pos - 1) * PW + col) : z4;
        x1[i] = *(const u32x4*)(base + (size_t)pos * PW + col);
        x2[i] = pos < SEQ - 1 ? *(const u32x4*)(base + (size_t)(pos + 1) * PW + col) : z4;
    }
    f32x4 wv[3][2];
#pragma unroll
    for (int t = 0; t < 3; ++t) { wv[t][0] = *(const f32x4*)(cw + t * 1024); wv[t][1] = *(const f32x4*)(cw + t * 1024 + 4); }
#pragma unroll
    for (int i = 0; i < 4; ++i) {
        const int pl = pl0 + 32 * i, tl = dir ? 127 - pl : pl;
        float sc = which ? 0.08838834764831845f : 1.f;
        if (wts) sc *= wts[tl];
        const unsigned a0[4] = {x0[i].x, x0[i].y, x0[i].z, x0[i].w}, a1[4] = {x1[i].x, x1[i].y, x1[i].z, x1[i].w}, a2[4] = {x2[i].x, x2[i].y, x2[i].z, x2[i].w};
        float y[8];
#pragma unroll
        for (int j = 0; j < 4; ++j) {
            const int e0 = 2 * j, e1 = 2 * j + 1;
            const float v0 = lo_f(a0[j]) * wv[0][e0 >> 2][e0 & 3] + lo_f(a1[j]) * wv[1][e0 >> 2][e0 & 3] + lo_f(a2[j]) * wv[2][e0 >> 2][e0 & 3];
            const float v1 = hi_f(a0[j]) * wv[0][e1 >> 2][e1 & 3] + hi_f(a1[j]) * wv[1][e1 >> 2][e1 & 3] + hi_f(a2[j]) * wv[2][e1 >> 2][e1 & 3];
            y[e0] = v0 * sigmoidf_(v0) * sc; y[e1] = v1 * sigmoidf_(v1) * sc;
        }
        u32x4 outv; outv.x = pk2(y[0], y[1]); outv.y = pk2(y[2], y[3]); outv.z = pk2(y[4], y[5]); outv.w = pk2(y[6], y[7]);
        *(u32x4*)(dst + tl * 144 + gch * 8) = outv;
    }
}
DI void mlstm_gates(const Params& P, int layer, int tokbase  , int h, int dir, int lane, float& i0, float& i1, float& f0, float& f1) {
    const float* ag = (const float*)(P.ws + WS_AG);
    const float* gb = P.in[4] + layer * 16;
    const int gi = (dir ? 8 : 0) + h, gf = (dir ? 12 : 4) + h;
    const int p0 = dir ? 127 - 2 * lane : 2 * lane, p1 = dir ? 126 - 2 * lane : 2 * lane + 1;
    i0 = ag[(size_t)(tokbase + p0) * 16 + gi] + gb[gi]; i1 = ag[(size_t)(tokbase + p1) * 16 + gi] + gb[gi];
    f0 = logsigmoidf_(ag[(size_t)(tokbase + p0) * 16 + gf] + gb[gf]); f1 = logsigmoidf_(ag[(size_t)(tokbase + p1) * 16 + gf] + gb[gf]);
}
DI bf16x8 scale8v(bf16x8 v, f32x4 wa, f32x4 wb) {
    const u32x4 u = __builtin_bit_cast(u32x4, v); u32x4 r;
    r.x = pk2(lo_f(u.x) * wa[0], hi_f(u.x) * wa[1]); r.y = pk2(lo_f(u.y) * wa[2], hi_f(u.y) * wa[3]);
    r.z = pk2(lo_f(u.z) * wb[0], hi_f(u.z) * wb[1]); r.w = pk2(lo_f(u.w) * wb[2], hi_f(u.w) * wb[3]);
    return __builtin_bit_cast(bf16x8, r);
}
DI void mlstm_a1_unit(const Params& P, int layer, int unit, unsigned char* smem) {
    const int tid = get_tid(), lane = tid & 63, w = tid >> 6, l15 = lane & 15, quad = lane >> 4;
    const int pc = unit & 31, h = (unit >> 5) & 3, b = unit >> 7;
    const bf16_t* base = (const bf16_t*)(P.ws + WS_PROJ) + (size_t)b * SEQ * PW;
    bf16_t* Kw = (bf16_t*)smem;
    bf16_t* Vv = Kw + 128 * 144;
    float* wp = (float*)(Vv + 128 * 144);
    float* scal = (float*)(P.ws + WS_SCAL);
    __syncthreads();
    if (w < 2) {
        const int dir = w, c = dir ? 31 - pc : pc, slot = ((b * 4 + h) * 2 + dir) * 32 + c;
        float i0, i1, f0, f1; mlstm_gates(P, layer, b * SEQ + pc * 128, h, dir, lane, i0, i1, f0, f1);
        float b0, b1; scan_add2(f0, f1, b0, b1, lane);
        const float bl = __shfl(b1, 63);
        const float g0 = bl - b0 + i0, g1 = bl - b1 + i1;
        float mloc = fmaxf(g0, g1);
#pragma unroll
        for (int o = 1; o < 64; o <<= 1) mloc = fmaxf(mloc, __shfl_xor(mloc, o));
        const int p0 = dir ? 127 - 2 * lane : 2 * lane, p1 = dir ? 126 - 2 * lane : 2 * lane + 1;
        wp[dir * 128 + p0] = fexp(g0 - mloc); wp[dir * 128 + p1] = fexp(g1 - mloc);
        if (lane == 0) { scal[slot] = bl; scal[1024 + slot] = mloc; }
    }
    mlstm_load_tile(P, layer, base, h, pc, 0, 1, nullptr, Kw);
    mlstm_load_tile(P, layer, base, h, pc, 0, 2, nullptr, Vv);
    __syncthreads();
    f32x4 acc[2][8];
#pragma unroll
    for (int dir = 0; dir < 2; ++dir)
#pragma unroll
        for (int d = 0; d < 8; ++d) acc[dir][d] = (f32x4){0.f, 0.f, 0.f, 0.f};
    const unsigned char* Kb = (const unsigned char*)Kw; const unsigned char* Vb = (const unsigned char*)Vv;
#pragma unroll
    for (int ks = 0; ks < 4; ++ks) {
        const int trow = ks * 32 + quad * 4 + (l15 >> 2), t0 = ks * 32 + quad * 4;
        const unsigned char* ka = Kb + trow * 288 + (w * 16 + (l15 & 3) * 4) * 2;
        const bf16x8 a = tr_pair(ka, ka + 16 * 288);
        const bf16x8 a0 = scale8v(a, *(const f32x4*)(wp + t0), *(const f32x4*)(wp + t0 + 16));
        const bf16x8 a1 = scale8v(a, *(const f32x4*)(wp + 128 + t0), *(const f32x4*)(wp + 128 + t0 + 16));
#pragma unroll
        for (int d = 0; d < 8; ++d) {
            const unsigned char* va = Vb + trow * 288 + (d * 16 + (l15 & 3) * 4) * 2;
            const bf16x8 vf = tr_pair(va, va + 16 * 288);
            acc[0][d] = mfma16(a0, vf, acc[0][d]); acc[1][d] = mfma16(a1, vf, acc[1][d]);
        }
    }
#pragma unroll
    for (int dir = 0; dir < 2; ++dir) {
        const int slot = ((b * 4 + h) * 2 + dir) * 32 + (dir ? 31 - pc : pc);
        bf16_t* cst = (bf16_t*)(P.ws + WS_CST) + (size_t)slot * 16384;
#pragma unroll
        for (int d = 0; d < 8; ++d) { u32x2 u; u.x = pk2(acc[dir][d][0], acc[dir][d][1]); u.y = pk2(acc[dir][d][2], acc[dir][d][3]); *(u32x2*)(cst + (d * 16 + l15) * 128 + w * 16 + quad * 4) = u; }
    }
    if (tid < 256) { const int dir = tid >> 7, dk = tid & 127; float n = 0.f;
        for (int t = 0; t < 128; ++t) n += bf2f(Kw[t * 144 + dk]) * wp[dir * 128 + t];
        const int slot = ((b * 4 + h) * 2 + dir) * 32 + (dir ? 31 - pc : pc);
        ((float*)(P.ws + WS_NST))[(size_t)slot * 128 + dk] = n; }
}
DI void mlstm_a2(const Params& P) {
    const int gtid = blockIdx.x * 512 + get_tid(), nth = gridDim.x * 512;
    float* scal = (float*)(P.ws + WS_SCAL);
    for (int task = gtid; task < 32 * 2048 + 32 * 128; task += nth) {
        if (task < 32 * 2048) {
            const int sc = task >> 11, vec = task & 2047;
            bf16_t* p = (bf16_t*)(P.ws + WS_CST) + (size_t)sc * 32 * 16384 + vec * 8;
            float C[8]; float m = 0.f;
#pragma unroll
            for (int j = 0; j < 8; ++j) C[j] = 0.f;
            for (int cb = 0; cb < 32; cb += 8) {
                u32x4 locv[8]; float blv[8], mlv[8];
#pragma unroll
                for (int j = 0; j < 8; ++j) { locv[j] = *(const u32x4*)(p + (size_t)(cb + j) * 16384); blv[j] = scal[sc * 32 + cb + j]; mlv[j] = scal[1024 + sc * 32 + cb + j]; }
#pragma unroll
                for (int j = 0; j < 8; ++j) {
                    const int c = cb + j; const u32x4 loc = locv[j];
                    u32x4 st; st.x = pk2(C[0], C[1]); st.y = pk2(C[2], C[3]); st.z = pk2(C[4], C[5]); st.w = pk2(C[6], C[7]);
                    *(u32x4*)(p + (size_t)c * 16384) = st;
                    if (vec == 0) scal[2048 + sc * 32 + c] = m;
                    const float bl = blv[j], ml = mlv[j];
                    const float mn = fmaxf(bl + m, ml), wc = fexp(bl + m - mn), wl = fexp(ml - mn);
                    C[0] = wc * C[0] + wl * lo_f(loc.x); C[1] = wc * C[1] + wl * hi_f(loc.x); C[2] = wc * C[2] + wl * lo_f(loc.y); C[3] = wc * C[3] + wl * hi_f(loc.y);
                    C[4] = wc * C[4] + wl * lo_f(loc.z); C[5] = wc * C[5] + wl * hi_f(loc.z); C[6] = wc * C[6] + wl * lo_f(loc.w); C[7] = wc * C[7] + wl * hi_f(loc.w);
                    m = mn;
                }
            }
        } else {
            const int t2 = task - 32 * 2048, sc = t2 >> 7, dk = t2 & 127;
            float* p = (float*)(P.ws + WS_NST) + (size_t)sc * 32 * 128 + dk;
            float n = 0.f, m = 0.f;
            for (int c = 0; c < 32; ++c) {
                const float loc = p[c * 128]; p[c * 128] = n;
                const float bl = scal[sc * 32 + c], ml = scal[1024 + sc * 32 + c];
                const float mn = fmaxf(bl + m, ml), wc = fexp(bl + m - mn), wl = fexp(ml - mn);
                n = wc * n + wl * loc; m = mn;
            }
        }
    }
}
DI void mlstm_a3_unit(const Params& P, int layer, int unit, unsigned char* smem, int do_store = 1) {
    const int tid = get_tid(), lane = tid & 63, w = tid >> 6, l15 = lane & 15, quad = lane >> 4;
    const int pc = unit & 31, h = (unit >> 5) & 3, b = unit >> 7;
    bf16_t* base = (bf16_t*)(P.ws + WS_PROJ) + (size_t)b * SEQ * PW;
    bf16_t* Qs = (bf16_t*)smem; bf16_t* Ks = Qs + 128 * 144; bf16_t* Vs = Ks + 128 * 144;
    float* arr = (float*)(Vs + 128 * 144);
    const float* scal = (const float*)(P.ws + WS_SCAL);
    f32x4 hacc[8];
#pragma unroll
    for (int d = 0; d < 8; ++d) hacc[d] = (f32x4){0.f, 0.f, 0.f, 0.f};
    __syncthreads();
    if (w < 2) {
        const int dir = w, slot = ((b * 4 + h) * 2 + dir) * 32 + (dir ? 31 - pc : pc);
        const float m = scal[2048 + slot];
        float* a_s = arr + dir * 512; float* M_t = a_s + 128; float* b_t = M_t + 128;
        float i0, i1, f0, f1; mlstm_gates(P, layer, b * SEQ + pc * 128, h, dir, lane, i0, i1, f0, f1);
        float b0, b1; scan_add2(f0, f1, b0, b1, lane);
        const float a0 = i0 - b0, a1 = i1 - b1;
        float p0, p1; scan_max2(a0, a1, p0, p1, lane);
        a_s[2 * lane] = a0; a_s[2 * lane + 1] = a1; M_t[2 * lane] = fmaxf(m, p0); M_t[2 * lane + 1] = fmaxf(m, p1); b_t[2 * lane] = b0; b_t[2 * lane + 1] = b1;
    } else if (w < 4) {
        const int dir = w - 2, slot = ((b * 4 + h) * 2 + dir) * 32 + (dir ? 31 - pc : pc);
        const float* np_ = (const float*)(P.ws + WS_NST) + (size_t)slot * 128; float* nv = arr + dir * 512 + 384; nv[lane] = np_[lane]; nv[lane + 64] = np_[lane + 64];
    }
    mlstm_load_tile(P, layer, base, h, pc, 0, 0, nullptr, Qs);
    mlstm_load_tile(P, layer, base, h, pc, 0, 1, nullptr, Ks);
    mlstm_load_tile(P, layer, base, h, pc, 0, 2, nullptr, Vs);
    __syncthreads();
#pragma unroll
    for (int dir = 0; dir < 2; ++dir) {
        const int c = dir ? 31 - pc : pc, sc = (b * 4 + h) * 2 + dir, slot = sc * 32 + c;
        const float m = scal[2048 + slot];
        const float* a_s = arr + dir * 512; const float* M_t = a_s + 128; const float* b_t = M_t + 128; const float* nv = b_t + 128;
        const int tl = dir ? 127 - (w * 16 + l15) : w * 16 + l15;
        const int tp = w * 16 + l15;
        const int rsgn = dir ? -1 : 1, roff = dir ? 127 : 0;
        const int nst = dir ? 8 - w : w + 1;
        bf16x8 qf[4];
#pragma unroll
        for (int ks = 0; ks < 4; ++ks) qf[ks] = *(const bf16x8*)(Qs + tp * 144 + ks * 32 + quad * 8);
        const float Mt = M_t[tl];
        bf16x8 pbv[4]; float rs_ = 0.f;
#pragma unroll
        for (int kg = 0; kg < 4; ++kg) {
            f32x4 zz[2];
#pragma unroll
            for (int hh = 0; hh < 2; ++hh) {
                const int s16 = 2 * kg + hh;
                f32x4 z = (f32x4){0.f, 0.f, 0.f, 0.f};
                if (s16 < nst) {
#pragma unroll
                    for (int ks = 0; ks < 4; ++ks) z = mfma16(*(const bf16x8*)(Ks + (roff + rsgn * (s16 * 16 + l15)) * 144 + ks * 32 + quad * 8), qf[ks], z);
#pragma unroll
                    for (int e = 0; e < 4; ++e) { const int s = s16 * 16 + quad * 4 + e; const float dv = (s <= tl) ? fexp(a_s[s] - Mt) : 0.f; z[e] *= dv; rs_ += z[e]; }
                }
                zz[hh] = z;
            }
            pbv[kg] = pack8(zz[0], zz[1]);
        }
        const float wi = fexp(m - Mt);
        f32x4 num[8];
#pragma unroll
        for (int d = 0; d < 8; ++d) num[d] = (f32x4){0.f, 0.f, 0.f, 0.f};
        const bf16_t* ct = (const bf16_t*)(P.ws + WS_CST) + (size_t)slot * 16384;
#pragma unroll
        for (int ks = 0; ks < 4; ++ks)
#pragma unroll
            for (int d = 0; d < 8; ++d) num[d] = mfma16(*(const bf16x8*)(ct + (d * 16 + l15) * 128 + ks * 32 + quad * 8), qf[ks], num[d]);
#pragma unroll
        for (int d = 0; d < 8; ++d) num[d] *= wi;
        const unsigned char* Vb = (const unsigned char*)Vs;
#pragma unroll
        for (int kg = 0; kg < 4; ++kg) {
            if (2 * kg < nst) {
                const bf16x8 pb = pbv[kg];
#pragma unroll
                for (int d = 0; d < 8; ++d) {
                    const unsigned char* a0 = Vb + (roff + rsgn * (kg * 32 + quad * 4 + (l15 >> 2))) * 288 + (d * 16 + (l15 & 3) * 4) * 2;
                    num[d] = mfma16(tr_pair(a0, a0 + rsgn * 16 * 288), pb, num[d]);
                }
            }
        }
        float qn = 0.f;
#pragma unroll
        for (int j = 0; j < 32; ++j) qn += bf2f(Qs[tp * 144 + quad * 32 + j]) * nv[quad * 32 + j];
        qn = quad_sum(qn); rs_ = quad_sum(rs_);
        const float den = wi * qn + rs_;
        const float inv = 1.f / fmaxf(fabsf(den), fexp(-(b_t[tl] + Mt)));
#pragma unroll
        for (int d = 0; d < 8; ++d)
#pragma unroll
            for (int e = 0; e < 4; ++e) hacc[d][e] += num[d][e] * inv;
    }
    float s1 = 0.f;
#pragma unroll
    for (int d = 0; d < 8; ++d)
#pragma unroll
        for (int e = 0; e < 4; ++e) s1 += hacc[d][e];
    const float mu = quad_sum(s1) * (1.f / 128.f);
    float s2 = 0.f;
#pragma unroll
    for (int d = 0; d < 8; ++d)
#pragma unroll
        for (int e = 0; e < 4; ++e) { const float t = hacc[d][e] - mu; s2 += t * t; }
    const float rstd = rsqrtf(quad_sum(s2) * (1.f / 128.f) + EPS);
    const float* ng = P.in[5] + layer * 512 + h * 128;
    bf16_t* op = base + (size_t)(pc * 128 + w * 16 + l15) * PW + C_AO + h * 128 + quad * 4;
#pragma unroll
    for (int d = 0; d < 8; ++d) {
        const u32x2 ob = *(const u32x2*)(op + d * 16); const f32x4 g = *(const f32x4*)(ng + d * 16 + quad * 4);
        const float y0 = (hacc[d][0] - mu) * rstd * g[0] * sigmoidf_(lo_f(ob.x)), y1 = (hacc[d][1] - mu) * rstd * g[1] * sigmoidf_(hi_f(ob.x));
        const float y2 = (hacc[d][2] - mu) * rstd * g[2] * sigmoidf_(lo_f(ob.y)), y3 = (hacc[d][3] - mu) * rstd * g[3] * sigmoidf_(hi_f(ob.y));
        u32x2 u; u.x = pk2(y0, y1); u.y = pk2(y2, y3); if (do_store) *(u32x2*)(op + d * 16) = u;
    }
}


#define XB_TMO      128
#define XB_XCNT(j)  (256  + 64 * (j))
#define XB_XSUB(j)  (1280 + 64 * (j))
#define XB_XGEN(j)  (2304 + 64 * (j))
#define XB_TOP      3328
#define XB_TOPGEN   3392
#define XCD_BAR_WORDS 3456
#define XB_SPIN_CAP (1u << 18)
DI unsigned xb_ld(unsigned* p)              { return __hip_atomic_load(p, __ATOMIC_RELAXED, __HIP_MEMORY_SCOPE_AGENT); }
DI unsigned xb_add(unsigned* p, unsigned v) { return __hip_atomic_fetch_add(p, v, __ATOMIC_RELAXED, __HIP_MEMORY_SCOPE_AGENT); }
DI unsigned xb_xcc_id() { return (unsigned)__builtin_amdgcn_s_getreg((3 << 11) | 20) & 0xFu; }
#define XB_SPIN(cond, bar) do { unsigned _sp = 0; while (cond) { __builtin_amdgcn_s_sleep(1); \
    if ((++_sp & 255u) == 0u) { if (xb_ld(&(bar)[XB_TMO])) break; if (_sp > XB_SPIN_CAP) { atomicAdd(&(bar)[XB_TMO], 1u); break; } } } } while (0)
struct XcdBarrier { unsigned* bar; unsigned x; volatile LAS unsigned* st; };
DI XcdBarrier xcd_barrier_post(unsigned* bar, volatile LAS unsigned* st) {
    XcdBarrier b; b.bar = bar; b.x = xb_xcc_id(); b.st = st;
    if (threadIdx.x == 0) (void)xb_add(&bar[XB_XCNT(b.x)], 1u);
    return b;
}
DI void xcd_barrier_complete(unsigned* bar, unsigned x, unsigned& nloc, unsigned& nx) {
    const unsigned G = gridDim.x * gridDim.y * gridDim.z;
    unsigned sum, cnt, mine, sp = 0u;
    for (;;) {
        sum = 0u; cnt = 0u; mine = 0u;
#pragma unroll
        for (unsigned j = 0; j < 16; ++j) { const unsigned c = xb_ld(&bar[XB_XCNT(j)]); sum += c; cnt += (c > 0u) ? 1u : 0u; mine = (j == x) ? c : mine; }
        if (sum == G) break;
        __builtin_amdgcn_s_sleep(1);
        if ((++sp & 255u) == 0u) { if (xb_ld(&bar[XB_TMO])) break; if (sp > XB_SPIN_CAP) { atomicAdd(&bar[XB_TMO], 1u); break; } }
    }
    nloc = mine > 0u ? mine : 1u; nx = cnt > 0u ? cnt : 1u;
}
DI void xcd_barrier(const XcdBarrier& b) {
    asm volatile("s_waitcnt vmcnt(0)" ::: "memory");
    __syncthreads();
    if (threadIdx.x == 0) {
        unsigned* bar = b.bar;
        __builtin_amdgcn_s_waitcnt(0);
        unsigned nloc = b.st[0], nx = b.st[1];
        if (nloc == 0u) { xcd_barrier_complete(bar, b.x, nloc, nx); b.st[0] = nloc; b.st[1] = nx; }
        const unsigned old = xb_add(&bar[XB_XSUB(b.x)], 1u);
        const unsigned gen = old / nloc;
        if (old + 1u == (gen + 1u) * nloc) {
            __builtin_amdgcn_fence(__ATOMIC_RELEASE, "agent");
            asm volatile("s_waitcnt vmcnt(0)" ::: "memory");
            const unsigned og = xb_add(&bar[XB_TOP], 1u);
            const unsigned tg = og / nx;
            if (og + 1u == (tg + 1u) * nx) xb_add(&bar[XB_TOPGEN], 1u);
            else XB_SPIN(xb_ld(&bar[XB_TOPGEN]) == tg, bar);
            __builtin_amdgcn_fence(__ATOMIC_ACQUIRE, "agent");
            xb_add(&bar[XB_XGEN(b.x)], 1u);
            asm volatile("s_waitcnt vmcnt(0)" ::: "memory");
        } else {
            XB_SPIN(xb_ld(&bar[XB_XGEN(b.x)]) == gen, bar);
            __builtin_amdgcn_fence(__ATOMIC_ACQUIRE, "agent");
            asm volatile("s_waitcnt vmcnt(0)" ::: "memory");
        }
    }
    __syncthreads();
}

__global__ void __launch_bounds__(512) fwd_megakernel(Params P) {
    extern __shared__ __attribute__((aligned(16))) unsigned char smem[];
    cg::grid_group grid = cg::this_grid();
    const int tid = get_tid(), bid = blockIdx.x, G = gridDim.x;
    const int gtid = bid * 512 + tid, nth = G * 512;
    bf16_t* hbuf = (bf16_t*)(P.ws + WS_H);
    volatile LAS unsigned* bst = (volatile LAS unsigned*)(smem + 131072);
    if (tid < 4) bst[tid] = 0u;
    __syncthreads();
    const XcdBarrier bar = xcd_barrier_post((unsigned*)P.ws, bst);

#ifndef REP_P0
#define REP_P0 1
#endif
    for (int rp0 = 0; rp0 < REP_P0; ++rp0)
    for (int l = 0; l < DEPTH; ++l) {
        unsigned char* wl = P.ws + WS_W + l * SZ_WLAYER;
        conv_mat<1>(P.in[2] + (size_t)l * 1024 * 10000, nullptr, 1024, 10000, (bf16_t*)wl, NIN, gtid, nth);
        for (int g = 0; g < 4; ++g) conv_mat<0>(P.in[14 + g] + (size_t)l * 512 * 1024, nullptr, 512, 1024, (bf16_t*)(wl + SZ_WIN) + (size_t)g * 1024 * 512, 1024, gtid, nth);
        conv_mat<0>(P.in[18] + (size_t)l * 1024 * 1024, nullptr, 1024, 1024, (bf16_t*)(wl + SZ_WIN + SZ_WUP), 1024, gtid, nth);
        conv_mat<2>(P.in[20] + (size_t)l * 1024 * DFF, P.in[21] + (size_t)l * 1024 * DFF, 1024, DFF, (bf16_t*)(wl + SZ_WIN + SZ_WUP + SZ_WOUT), NFF2, gtid, nth);
        conv_mat<0>(P.in[22] + (size_t)l * DFF * 1024, nullptr, DFF, 1024, (bf16_t*)(wl + SZ_WIN + SZ_WUP + SZ_WOUT + SZ_WGU), 1024, gtid, nth);
    }
    if (gtid < DEPTH) {
        const int l = gtid; float d1 = 0.f, d2 = 0.f;
        for (int i = 0; i < 64; ++i) { d1 += P.in[9][l * 64 + i] * P.in[10][l * 64 + i]; d2 += P.in[11][l * 64 + i] * P.in[12][l * 64 + i]; }
        const float linit = l == 0 ? 0.2f : 0.35550906f;
        ((float*)(P.ws + WS_LAM))[l] = expf(d1) - expf(d2) + linit;
    }
    norm_rows(P.in[0], P.in[1], hbuf, nullptr, T);
    grid.sync();

#pragma unroll 1
    for (int layer_ = 0; layer_ < DEPTH; ++layer_) {
#ifndef REP_A
#define REP_A 1
#endif
#ifndef REP_N
#define REP_N 1
#endif
#ifndef REP_B
#define REP_B 1
#endif
#ifndef REP_D
#define REP_D 1
#endif
#ifndef REP_GEMM
#define REP_GEMM 1
#endif
#ifndef REP_ATTN
#define REP_ATTN 1
#endif
#define REPEAT(n) for (int rep_ = 0; rep_ < (n); ++rep_)
#define LASTREP(n) int dst_ = (rep_ == (n) - 1); asm volatile("" : "+s"(dst_));
#define LAUNDER() int layer = layer_; asm volatile("" : "+s"(layer)); Params Q = P; { size_t z_ = 0; asm volatile("" : "+s"(z_)); Q.ws = P.ws + z_; }     const unsigned char* wl = Q.ws + WS_W + layer * SZ_WLAYER; (void)wl;
#pragma unroll 1
        for (int hb_ = 0; hb_ < 2; ++hb_) {
            REPEAT(REP_GEMM) { LAUNDER(); int hb = hb_; asm volatile("" : "+s"(hb));
              EpiInProj E{(bf16_t*)(Q.ws + WS_PROJ), (float*)(Q.ws + WS_AG)}; pg8_run((const bf16_t*)(Q.ws + WS_H) + (size_t)hb * HALF_T * 1024, (const bf16_t*)wl, HALF_T, NIN, 1024, E, smem); }
            xcd_barrier(bar);
            { LAUNDER();
              prep_b(Q, layer);
              REPEAT(REP_A) for (int u = bid; u < 512; u += G) mlstm_a1_unit(Q, layer, u, smem); }
            { LAUNDER();
                float* rpb_lds = (float*)(smem + 8 * 10240);
                __syncthreads();
                for (int i = get_tid(); i < 3720; i += 512) rpb_lds[i] = Q.in[8][layer * 3720 + i];
                __syncthreads();
                REPEAT(REP_N) { LASTREP(REP_N); for (int u = vt_index(0); u < 1024; u += G) natten_iter(Q, u, rpb_lds, smem, dst_); }
            }
            xcd_barrier(bar);
            { LAUNDER(); mlstm_a2(Q); }
            REPEAT(REP_D) { LAUNDER(); LASTREP(REP_D); for (int u = vt_index(0); u < 512; u += G) attn_d_unit(Q, layer, u, smem, dst_); }
            REPEAT(REP_B) { LAUNDER(); LASTREP(REP_B); for (int u = vt_index(0); u < 512; u += G) attn_b_unit(Q, u, smem, dst_); }
            xcd_barrier(bar);
            REPEAT(REP_A) { LAUNDER(); LASTREP(REP_A); for (int u = bid; u < 512; u += G) mlstm_a3_unit(Q, layer, u, smem, dst_); }
            xcd_barrier(bar);
            REPEAT(REP_GEMM) { LAUNDER(); int hb = hb_; asm volatile("" : "+s"(hb)); merge_phase(Q, layer, hb, smem); }
            xcd_barrier(bar);
        }
        REPEAT(REP_GEMM) { LAUNDER(); LASTREP(REP_GEMM);
          bf16_t* xr = (bf16_t*)(Q.ws + WS_XR);
          EpiResid E{layer == 0 ? Q.in[0] : nullptr, xr, xr, dst_}; pg8_run((const bf16_t*)(Q.ws + WS_H), (const bf16_t*)(wl + SZ_WIN + SZ_WUP), T, 1024, 1024, E, smem); }
        xcd_barrier(bar);
        { LAUNDER(); norm_rows_b((const bf16_t*)(Q.ws + WS_XR), Q.in[19] + layer * 1024, (bf16_t*)(Q.ws + WS_H), nullptr, T); }
        xcd_barrier(bar);
        REPEAT(REP_GEMM) { LAUNDER();
          EpiSwiglu E{(bf16_t*)(Q.ws + WS_PROJ)}; pg8_run((const bf16_t*)(Q.ws + WS_H), (const bf16_t*)(wl + SZ_WIN + SZ_WUP + SZ_WOUT), T, NFF2, 1024, E, smem); }
        xcd_barrier(bar);
        REPEAT(REP_GEMM) { LAUNDER(); LASTREP(REP_GEMM);
          bf16_t* xr = (bf16_t*)(Q.ws + WS_XR);
          EpiResid E{nullptr, xr, xr, dst_}; pg8_run((const bf16_t*)(Q.ws + WS_PROJ), (const bf16_t*)(wl + SZ_WIN + SZ_WUP + SZ_WOUT + SZ_WGU), T, 1024, DFF, E, smem); }
        xcd_barrier(bar);
        { LAUNDER();
          if (layer + 1 < DEPTH) norm_rows_b((const bf16_t*)(Q.ws + WS_XR), Q.in[1] + (layer + 1) * 1024, (bf16_t*)(Q.ws + WS_H), nullptr, T);
          else norm_rows_b((const bf16_t*)(Q.ws + WS_XR), Q.in[23], nullptr, Q.out, T); }
        xcd_barrier(bar);
    }
}

extern "C" void kernel_launch(void* const* d_in, const int* in_sizes, int n_in, void* d_out, int out_size, void* d_ws, size_t ws_size, hipStream_t stream) {
    static int grid_blocks = 0;
    if (grid_blocks == 0) {
        if (n_in != 24 || out_size != T * DM || ws_size < WS_END) {
            fprintf(stderr, "kernel_launch: unexpected shapes: n_in %d out %d ws %zu (need %zu)\n", n_in, out_size, ws_size, (size_t)WS_END); grid_blocks = -1; return; }
        int dev = 0, cus = 0, per_cu = 0;
        hipGetDevice(&dev);
        hipDeviceGetAttribute(&cus, hipDeviceAttributeMultiprocessorCount, dev);
        if (hipFuncSetAttribute((const void*)fwd_megakernel, hipFuncAttributeMaxDynamicSharedMemorySize, LDS_BYTES) != hipSuccess) { fprintf(stderr, "kernel_launch: hipFuncSetAttribute failed\n"); }
        hipOccupancyMaxActiveBlocksPerMultiprocessor(&per_cu, (const void*)fwd_megakernel, 512, LDS_BYTES);
        if (per_cu < 1) { fprintf(stderr, "kernel_launch: occupancy query says %d blocks/CU\n", per_cu); per_cu = 1; }
        grid_blocks = cus;
        (void)hipGetLastError();
    }
    if (grid_blocks < 0) return;
    Params p{};
    for (int i = 0; i < 24; ++i) p.in[i] = (const float*)d_in[i];
    p.out = (float*)d_out; p.ws = (unsigned char*)d_ws;
    if (hipMemsetAsync(d_ws, 0, 16384, stream) != hipSuccess) { fprintf(stderr, "kernel_launch: memset of barrier words failed\n"); return; }
    void* args[] = {&p};
    hipError_t e = hipLaunchCooperativeKernel((const void*)fwd_megakernel, dim3(grid_blocks), dim3(512), args, LDS_BYTES, stream);
    if (e != hipSuccess) fprintf(stderr, "cooperative launch failed: %s (grid %d)\n", hipGetErrorString(e), grid_blocks);
}
```
